# Optimizing an MI355X kernel written in HIP

```python
import math
import jax
import jax.numpy as jnp
from jax import lax
import numpy as np

D_MODEL = 2048
BATCH = 4
SEQ = 8192
DEPTH = 2

N_MEM = 256
N_GROUPS = 4
GROUP_WIDTH = D_MODEL // N_GROUPS
HEADS = 4
HEAD_V = GROUP_WIDTH // HEADS
GLA_DK = HEAD_V // 2
GLA_GATE_RANK = 16
GLA_GATE_NORM = 16.0
HGRN_DK = HEAD_V
DIFF_DK = HEAD_V // 2
MLSTM_DK = HEAD_V // 2
CONV_WIDTH = 4
CHUNK = 64
Q_BLOCK = 128
T5_BUCKETS = 32
T5_MAX_DIST = 128
N_XHEADS = 4
XHEAD_DIM = D_MODEL // N_XHEADS
D_FF = 5632
LN_EPS = 1e-5
LB_EPS = 1e-12
MASK_NEG = -1e30
F32 = jnp.float32

IN_SPLITS = (
    HEADS * GLA_DK, HEADS * GLA_DK, GROUP_WIDTH, GLA_GATE_RANK, GROUP_WIDTH,
    HEADS * HGRN_DK, HEADS * HGRN_DK, GROUP_WIDTH, GROUP_WIDTH,
    2 * HEADS * DIFF_DK, 2 * HEADS * DIFF_DK, GROUP_WIDTH,
    HEADS * MLSTM_DK, HEADS * MLSTM_DK, GROUP_WIDTH, 2 * HEADS, GROUP_WIDTH,
)
N_IN = sum(IN_SPLITS)

kernel_name = 'hybrid_parallel_heads_decoder'


def layer_norm(x, g, b):
    xf = x.astype(F32)
    mu = jnp.mean(xf, -1, keepdims=True)
    var = jnp.mean(jnp.square(xf - mu), -1, keepdims=True)
    return ((xf - mu) * lax.rsqrt(var + LN_EPS) * g.astype(F32) + b.astype(F32)).astype(x.dtype)


def rms_norm(x, g):
    xf = x.astype(F32)
    return xf * lax.rsqrt(jnp.mean(xf * xf, -1, keepdims=True) + LN_EPS) * g.astype(F32)


def swiglu_ffn(x, w_in, w_out):
    gate, up = jnp.split(x @ w_in, 2, axis=-1)
    return (jax.nn.silu(gate) * up) @ w_out


def to_heads(t, h):
    b, s, hd = t.shape
    return t.reshape(b, s, h, hd // h).transpose(0, 2, 1, 3)


def from_heads(t):
    b, h, s, d = t.shape
    return t.transpose(0, 2, 1, 3).reshape(b, s, h * d)


def to_chunks(t):
    b, h, s = t.shape[:3]
    return jnp.moveaxis(t.reshape(b, h, s // CHUNK, CHUNK, *t.shape[3:]), 2, 0)


def from_chunks(t):
    t = jnp.moveaxis(t, 0, 2)
    return t.reshape(t.shape[0], t.shape[1], -1, t.shape[-1])


def chunked_gated_linear_attention(q, k, v, log_g):
    b, h, _, dk = q.shape
    dv = v.shape[-1]
    causal = jnp.tril(jnp.ones((CHUNK, CHUNK), dtype=bool))[:, :, None]

    def step(state, inp):
        qc, kc, vc, gc = inp
        cum = jnp.cumsum(gc.astype(F32), axis=2)
        o_inter = jnp.einsum('bhcd,bhde->bhce', qc * jnp.exp(cum), state)
        diff = cum[:, :, :, None, :] - cum[:, :, None, :, :]
        decay = jnp.where(causal, jnp.exp(jnp.where(causal, diff, 0.0)), 0.0)
        attn = jnp.einsum('bhid,bhjd,bhijd->bhij', qc, kc, decay)
        o_intra = jnp.einsum('bhij,bhje->bhie', attn, vc)
        last = cum[:, :, -1:, :]
        new_state = jnp.exp(last[:, :, 0, :])[..., None] * state + jnp.einsum('bhcd,bhce->bhde', kc * jnp.exp(last - cum), vc)
        return new_state, o_inter + o_intra

    state0 = jnp.zeros((b, h, dk, dv), F32)
    _, o = lax.scan(step, state0, (to_chunks(q), to_chunks(k), to_chunks(v), to_chunks(log_g)))
    return from_chunks(o)


def chunked_mlstm(q, k, v, log_i, log_f):
    b, h, _, dk = q.shape
    dv = v.shape[-1]
    causal = jnp.tril(jnp.ones((CHUNK, CHUNK), dtype=bool))

    def step(carry, inp):
        c_st, n_st, m_st = carry
        qc, kc, vc, ic, fc = inp
        ic = ic.astype(F32)
        cum = jnp.cumsum(fc.astype(F32), axis=-1)
        log_inter = cum + m_st[..., None]
        log_intra = jnp.where(causal, cum[..., :, None] - cum[..., None, :] + ic[..., None, :], MASK_NEG)
        m_t = jnp.maximum(log_inter, jnp.max(log_intra, axis=-1))
        w_inter = jnp.exp(log_inter - m_t)
        w_intra = jnp.where(causal, jnp.exp(log_intra - m_t[..., None]), 0.0)
        scores = jnp.einsum('bhid,bhjd->bhij', qc, kc) * w_intra
        num = w_inter[..., None] * jnp.einsum('bhcd,bhde->bhce', qc, c_st) + jnp.einsum('bhij,bhje->bhie', scores, vc)
        den = w_inter * jnp.einsum('bhcd,bhd->bhc', qc, n_st) + jnp.sum(scores, axis=-1)
        h_t = num / jnp.maximum(jnp.abs(den), jnp.exp(-m_t))[..., None]
        log_last_inter = cum[..., -1] + m_st
        log_last_intra = cum[..., -1:] - cum + ic
        m_new = jnp.maximum(log_last_inter, jnp.max(log_last_intra, axis=-1))
        wk = jnp.exp(log_last_intra - m_new[..., None])
        dec = jnp.exp(log_last_inter - m_new)
        c_new = dec[..., None, None] * c_st + jnp.einsum('bhcd,bhce->bhde', kc * wk[..., None], vc)
        n_new = dec[..., None] * n_st + jnp.einsum('bhcd,bhc->bhd', kc, wk)
        return (c_new, n_new, m_new), h_t

    carry0 = (jnp.zeros((b, h, dk, dv), F32), jnp.zeros((b, h, dk), F32), jnp.zeros((b, h), F32))
    _, o = lax.scan(step, carry0, (to_chunks(q), to_chunks(k), to_chunks(v), to_chunks(log_i), to_chunks(log_f)))
    return from_chunks(o)


def t5_bucket(rel):
    n = jnp.maximum(rel, 0)
    max_exact = T5_BUCKETS // 2
    large = max_exact + (jnp.log(jnp.maximum(n, 1).astype(F32) / max_exact)
                         / math.log(T5_MAX_DIST / max_exact) * (T5_BUCKETS - max_exact)).astype(jnp.int32)
    large = jnp.clip(large, max_exact, T5_BUCKETS - 1)
    return jnp.where(n < max_exact, n, large)


def differential_attention(q, k, v, lam, t5_table, norm_g, lambda_init):
    b, h, s, _ = q.shape
    nb = s // Q_BLOCK
    q1, q2 = jnp.split(q * DIFF_DK ** -0.5, 2, axis=-1)
    k1, k2 = jnp.split(k, 2, axis=-1)
    blocks = lambda t: t.reshape(b, h, nb, Q_BLOCK, DIFF_DK).transpose(2, 0, 1, 3, 4)
    k_pos = jnp.arange(s)

    def block(args):
        i, q1b, q2b = args
        q_pos = i * Q_BLOCK + jnp.arange(Q_BLOCK)
        rel = q_pos[:, None] - k_pos[None, :]
        bias = jnp.transpose(t5_table[t5_bucket(rel)], (2, 0, 1)).astype(F32)
        mask = rel >= 0

        def probs(qq, kk):
            logits = jnp.einsum('bhqd,bhkd->bhqk', qq, kk).astype(F32) + bias
            return jax.nn.softmax(jnp.where(mask, logits, MASK_NEG), axis=-1)

        w = probs(q1b, k1) - lam * probs(q2b, k2)
        return jnp.einsum('bhqk,bhkd->bhqd', w.astype(v.dtype), v)

    out = lax.map(block, (jnp.arange(nb), blocks(q1), blocks(q2)))
    out = out.transpose(1, 2, 0, 3, 4).reshape(b, h, s, -1)
    return rms_norm(out, norm_g) * (1.0 - lambda_init)


def causal_dwconv(x, w):
    return lax.conv_general_dilated(x, w[:, None, :].astype(x.dtype), window_strides=(1,),
                                    padding=[(CONV_WIDTH - 1, 0)], dimension_numbers=('NWC', 'WIO', 'NWC'),
                                    feature_group_count=x.shape[-1])


def hybrid_mixer(h, layer, w_in, w_out, gla_gate_w, gla_gate_b, gla_norm_g, lb, hgrn_norm_g,
                 diff_lambda, diff_norm_g, t5_table, mlstm_conv_w, mlstm_gate_b):
    proj = h @ w_in
    (a_q, a_k, a_v, a_lr, a_r, b_q, b_f, b_i, b_g, c_q, c_k, c_v,
     d_q, d_k, d_v, d_if, d_o) = jnp.split(proj, list(np.cumsum(IN_SPLITS)[:-1]), axis=-1)

    a_logg = jax.nn.log_sigmoid((a_lr @ gla_gate_w + gla_gate_b).astype(F32)) / GLA_GATE_NORM
    o_a = chunked_gated_linear_attention(to_heads(a_q, HEADS) * GLA_DK ** -0.5, to_heads(a_k, HEADS),
                                         to_heads(a_v, HEADS), to_heads(a_logg, HEADS))
    o_a = from_heads(rms_norm(o_a, gla_norm_g)) * jax.nn.silu(a_r.astype(F32))

    f_pre = b_f.astype(F32)
    lb = lb.astype(F32)
    log_f = jnp.logaddexp(jnp.log(jnp.maximum(lb, LB_EPS)), jnp.log1p(-lb) + jax.nn.log_sigmoid(f_pre))
    k_b = (1.0 - lb) * jax.nn.sigmoid(-f_pre)
    o_b = chunked_gated_linear_attention(to_heads(jax.nn.silu(b_q), HEADS) * HGRN_DK ** -0.5, to_heads(k_b, HEADS),
                                         to_heads(b_i, HEADS), to_heads(log_f, HEADS))
    o_b = from_heads(rms_norm(o_b, hgrn_norm_g)) * jax.nn.silu(b_g.astype(F32))

    lambda_init = 0.8 - 0.6 * math.exp(-0.3 * layer)
    lq1, lk1, lq2, lk2 = [diff_lambda[j].astype(F32) for j in range(4)]
    lam = jnp.exp(jnp.sum(lq1 * lk1)) - jnp.exp(jnp.sum(lq2 * lk2)) + lambda_init
    o_c = differential_attention(to_heads(c_q, HEADS), to_heads(c_k, HEADS), to_heads(c_v, HEADS),
                                 lam, t5_table, diff_norm_g, lambda_init)
    o_c = from_heads(o_c)

    qk = jax.nn.silu(causal_dwconv(jnp.concatenate([d_q, d_k], axis=-1), mlstm_conv_w))
    d_qc, d_kc = jnp.split(qk, 2, axis=-1)
    gates = (d_if + mlstm_gate_b).astype(F32)
    log_i = gates[..., :HEADS].transpose(0, 2, 1)
    log_fd = jax.nn.log_sigmoid(gates[..., HEADS:]).transpose(0, 2, 1)
    o_d = chunked_mlstm(to_heads(d_qc, HEADS), to_heads(d_kc, HEADS) * MLSTM_DK ** -0.5, to_heads(d_v, HEADS), log_i, log_fd)
    o_d = from_heads(o_d) * jax.nn.sigmoid(d_o.astype(F32))

    mixed = jnp.concatenate([o_a, o_b, o_c, o_d], axis=-1).astype(h.dtype)
    return mixed @ w_out


def memory_cross_attention(h, mem, w_q, w_kv, w_o):
    q = to_heads(h @ w_q, N_XHEADS)
    k, v = jnp.split(mem @ w_kv, 2, axis=-1)
    k, v = to_heads(k, N_XHEADS), to_heads(v, N_XHEADS)
    logits = jnp.einsum('bhqd,bhkd->bhqk', q, k).astype(F32) * XHEAD_DIM ** -0.5
    p = jax.nn.softmax(logits, axis=-1).astype(v.dtype)
    return from_heads(jnp.einsum('bhqk,bhkd->bhqd', p, v)) @ w_o


def setup_inputs(seed: int = 0) -> dict:
    key = jax.random.key(seed)
    ks = jax.random.split(key, 24)
    nrm = lambda k, shape, scale: scale * jax.random.normal(k, shape, F32)
    beta = (8 * DEPTH) ** -0.25
    mlstm_gate_b = jnp.concatenate(
        [nrm(ks[17], (DEPTH, HEADS), 0.1),
         jnp.linspace(3.0, 6.0, HEADS, dtype=F32)[None, :] + nrm(ks[18], (DEPTH, HEADS), 0.1)], axis=-1)
    return {
        'x': nrm(ks[0], (BATCH, SEQ, D_MODEL), 1.0),
        'mem': nrm(ks[1], (BATCH, N_MEM, D_MODEL), 1.0),
        'ln_g': 1.0 + nrm(ks[2], (DEPTH, 4, D_MODEL), 0.02),
        'ln_b': nrm(ks[3], (DEPTH, 4, D_MODEL), 0.02),
        'ffn_w_in': nrm(ks[4], (DEPTH, 2, D_MODEL, 2 * D_FF), D_MODEL ** -0.5),
        'ffn_w_out': nrm(ks[5], (DEPTH, 2, D_FF, D_MODEL), beta * D_FF ** -0.5),
        'w_in': nrm(ks[6], (DEPTH, D_MODEL, N_IN), D_MODEL ** -0.5),
        'w_out': nrm(ks[7], (DEPTH, D_MODEL, D_MODEL), beta * D_MODEL ** -0.5),
        'gla_gate_w': nrm(ks[8], (DEPTH, GLA_GATE_RANK, HEADS * GLA_DK), GLA_GATE_RANK ** -0.5),
        'gla_gate_b': nrm(ks[9], (DEPTH, HEADS * GLA_DK), 0.1),
        'gla_norm_g': 1.0 + nrm(ks[10], (DEPTH, HEAD_V), 0.02),
        'hgrn_lb': nrm(ks[11], (DEPTH, HEADS * HGRN_DK), 0.5),
        'hgrn_norm_g': 1.0 + nrm(ks[12], (DEPTH, HEAD_V), 0.02),
        'diff_lambda': nrm(ks[13], (DEPTH, 4, DIFF_DK), 0.1),
        'diff_norm_g': 1.0 + nrm(ks[14], (DEPTH, 2 * DIFF_DK), 0.02),
        't5_table': nrm(ks[15], (T5_BUCKETS, HEADS), 0.5),
        'mlstm_conv_w': nrm(ks[16], (DEPTH, CONV_WIDTH, 2 * HEADS * MLSTM_DK), CONV_WIDTH ** -0.5),
        'mlstm_gate_b': mlstm_gate_b,
        'xattn_w_q': nrm(ks[19], (DEPTH, D_MODEL, D_MODEL), D_MODEL ** -0.5),
        'xattn_w_kv': nrm(ks[20], (DEPTH, D_MODEL, 2 * D_MODEL), D_MODEL ** -0.5),
        'xattn_w_o': nrm(ks[21], (DEPTH, D_MODEL, D_MODEL), beta * D_MODEL ** -0.5),
    }


def reference(x, mem, ln_g, ln_b, ffn_w_in, ffn_w_out, w_in, w_out, gla_gate_w, gla_gate_b, gla_norm_g,
              hgrn_lb, hgrn_norm_g, diff_lambda, diff_norm_g, t5_table, mlstm_conv_w, mlstm_gate_b,
              xattn_w_q, xattn_w_kv, xattn_w_o):
    alpha = (2 * DEPTH) ** 0.25
    sm = jax.nn.softmax(hgrn_lb.astype(F32), axis=0)
    lower_bounds = jnp.clip(jnp.cumsum(sm, axis=0) - sm[0], 0.0, 1.0 - 1e-6)
    for l in range(DEPTH):
        x = layer_norm(alpha * x + 0.5 * swiglu_ffn(x, ffn_w_in[l, 0], ffn_w_out[l, 0]), ln_g[l, 0], ln_b[l, 0])
        mix = hybrid_mixer(x, l, w_in[l], w_out[l], gla_gate_w[l], gla_gate_b[l], gla_norm_g[l], lower_bounds[l],
                           hgrn_norm_g[l], diff_lambda[l], diff_norm_g[l], t5_table, mlstm_conv_w[l], mlstm_gate_b[l])
        x = layer_norm(alpha * x + mix, ln_g[l, 1], ln_b[l, 1])
        x = layer_norm(alpha * x + memory_cross_attention(x, mem, xattn_w_q[l], xattn_w_kv[l], xattn_w_o[l]), ln_g[l, 2], ln_b[l, 2])
        x = layer_norm(alpha * x + 0.5 * swiglu_ffn(x, ffn_w_in[l, 1], ffn_w_out[l, 1]), ln_g[l, 3], ln_b[l, 3])
    return x
```

```cpp
#include <hip/hip_runtime.h>
#include <hip/hip_bf16.h>
#include <cstdio>
#include <cstdint>
#include <cmath>

#define LAS __attribute__((address_space(3)))
#define GAS __attribute__((address_space(1)))
typedef unsigned short bf16_t;
typedef short bf16x8 __attribute__((ext_vector_type(8)));
typedef short s16x4 __attribute__((ext_vector_type(4)));
typedef float f32x4 __attribute__((ext_vector_type(4)));
typedef float f32x2 __attribute__((ext_vector_type(2)));
typedef float f32x16 __attribute__((ext_vector_type(16)));
typedef unsigned u32x4 __attribute__((ext_vector_type(4)));
typedef unsigned u32x2 __attribute__((ext_vector_type(2)));

constexpr int D = 2048, BATCH = 4, SEQ = 8192, M = BATCH * SEQ, DEPTH = 2, NMEM = 256, DFF = 5632;
constexpr int NIN = 6680, NPROJ = 6912;
constexpr float LN_EPS = 1e-5f;
constexpr float ALPHA = 1.41421356237309515f;
constexpr float LOG2E = 1.4426950408889634f;
constexpr int PQ_A = 0, PK_A = 256, PV_A = 512, PR_A = 1024, PQ_B = 1536, PF_B = 2048, PI_B = 2560, PG_B = 3072,
              PQ_C = 3584, PK_C = 4096, PV_C = 4608, PQ_D = 5120, PK_D = 5376, PV_D = 5632, PO_D = 6144, P_SMALL = 6656;

__device__ __forceinline__ int lane_id() { int l; asm volatile("v_mbcnt_lo_u32_b32 %0, -1, 0\n\tv_mbcnt_hi_u32_b32 %0, -1, %0" : "=v"(l)); return l; }
__device__ __forceinline__ float shx(float v, int m, int lane) { return __int_as_float(__builtin_amdgcn_ds_bpermute((lane ^ m) << 2, __float_as_int(v))); }
typedef __bf16 bf16x2_t __attribute__((ext_vector_type(2)));
__device__ __forceinline__ unsigned cvt_pk_bf16(float lo, float hi) { unsigned r; asm volatile("v_cvt_pk_bf16_f32 %0, %1, %2" : "=v"(r) : "v"(lo), "v"(hi)); return r; }
__device__ __forceinline__ unsigned cvt_pk_bf16_c(float lo, float hi) { f32x2 v = {lo, hi}; bf16x2_t b = __builtin_convertvector(v, bf16x2_t); return __builtin_bit_cast(unsigned, b); }
__device__ __forceinline__ float bf2f(unsigned short b) { return __uint_as_float(((unsigned)b) << 16); }
__device__ __forceinline__ float bflo(unsigned w) { return __uint_as_float(w << 16); }
__device__ __forceinline__ float bfhi(unsigned w) { return __uint_as_float(w & 0xffff0000u); }
__device__ __forceinline__ unsigned short f2bf(float f) { return (unsigned short)(cvt_pk_bf16_c(f, 0.f) & 0xffffu); }
__device__ __forceinline__ float fast_exp2(float x) { return __builtin_amdgcn_exp2f(x); }
__device__ __forceinline__ float fast_exp(float x) { return __builtin_amdgcn_exp2f(x * LOG2E); }
__device__ __forceinline__ float fast_rcp(float x) { return __builtin_amdgcn_rcpf(x); }
__device__ __forceinline__ float sigmoidf_(float x) { return fast_rcp(1.f + fast_exp(-x)); }
__device__ __forceinline__ float siluf_(float x) { return x * sigmoidf_(x); }
__device__ __forceinline__ float logsigmoidf_(float x) { return fminf(x, 0.f) - log1pf(__expf(-fabsf(x))); }

namespace pg8 {
constexpr int BM = 256, BK = 64, HALF = 128, HTB = HALF * BK * 2, STAGE_BYTES = 8 * HTB, NXCD = 8, WGM = 8;
__host__ __device__ __forceinline__ int lds_byte(int r, int c) { const int st = (r >> 4) * 2 + (c >> 5), rr = r & 15, cc = c & 31, ob = rr * 64 + cc * 2; return st * 1024 + (ob ^ (((ob >> 9) & 1) << 5)); }
__host__ __device__ __forceinline__ void stage_rc(int b, int& R, int& C) { const int st = b / 1024, sb = b % 1024, swz = sb ^ (((sb >> 9) & 1) << 5); R = (st >> 1) * 16 + swz / 64; C = (st & 1) * 32 + (swz % 64) / 2; }
__host__ __device__ __forceinline__ int perm32(int rho) { const int n = rho >> 4, i = rho & 15; return 8 * (i >> 2) + 4 * n + (i & 3); }

struct Unit { int pm, pn; unsigned aoff, boff, coff; };
struct Gemm { const bf16_t* A; const bf16_t* Bt; };

struct StaticOrder {
    int nM, nN, nwg, G, c, lda, ldb, ldc, cw;
    __device__ void init(int Mr, int Nc, int G_, int c_, int lda_, int ldb_, int ldc_, int cw_) { nM = Mr / BM; nN = Nc / BM; nwg = nM * nN; G = G_; c = c_; lda = lda_; ldb = ldb_; ldc = ldc_; cw = cw_; }
    __device__ bool next(int i, Unit& u) const {
        const long L = (long)i * G + c; if (L >= nwg || c < 0) return false;
        int wgid = (int)L; { const int q = nwg / NXCD, r = nwg % NXCD, xcd = wgid % NXCD, off = wgid / NXCD; wgid = (xcd < r ? xcd * (q + 1) : r * (q + 1) + (xcd - r) * q) + off; }
        const int nig = WGM * nN, gid = wgid / nig, fm = gid * WGM, gsz = (nM - fm) < WGM ? (nM - fm) : WGM;
        u.pm = fm + ((wgid % nig) % gsz); u.pn = (wgid % nig) / gsz;
        u.aoff = (unsigned)(u.pm * BM) * (unsigned)lda; u.boff = (unsigned)(u.pn * BM) * (unsigned)ldb; u.coff = (unsigned)(u.pm * BM) * (unsigned)ldc + (unsigned)(u.pn * cw); return true;
    }
};

template <int LDA, int LDB, int KK, class Epi, class Sched>
__device__ __forceinline__ void gemm_phase(LAS unsigned char* lds, int wave, const Gemm g, const Sched& S, const Epi& E) {
    int tid_ = wave * 64 + lane_id();
    int wid_ = wave; asm volatile("" : "+s"(wid_));
    const int tid = tid_, wid = wid_, lane = tid & 63, wr = wid >> 2, wc = wid & 3, fr = lane & 15, fq = lane >> 4;
    constexpr int nt = KK / BK;
    unsigned voffA[2], voffB[2];
#pragma unroll
    for (int i = 0; i < 2; ++i) { int R, C; stage_rc(tid * 16 + i * 8192, R, C); const int Rb = Epi::PERM ? ((R & ~31) + perm32(R & 31)) : R;
        voffA[i] = (unsigned)(R * LDA + C) * 2u; voffB[i] = (unsigned)(Rb * LDB + C) * 2u; }
    constexpr size_t kstep = (size_t)(BK * 2);
    constexpr size_t hstepA = (size_t)HALF * LDA * 2, hstepB = (size_t)HALF * LDB * 2;
    const unsigned ldsw = (unsigned)wid * 1024u;
    const int aoff = lds_byte(wr * 64 + fr, fq * 8), boff = lds_byte(wc * 32 + fr, fq * 8);
#define PG8_SA(b, h) (((b) * 2 + (h)) * HTB)
#define PG8_SB(b, h) ((4 + (b) * 2 + (h)) * HTB)
#define PG8_STAGE(bufoff, gbase, voff) do { _Pragma("unroll") for (int _i = 0; _i < 2; ++_i) \
        __builtin_amdgcn_global_load_lds((const unsigned*)((const char*)(gbase) + (voff)[_i]), (LAS unsigned*)(lds + (bufoff) + ldsw + _i * 8192), 16, 0, 0); } while (0)
#define PG8_LDA(dst, b, h) do { _Pragma("unroll") for (int m = 0; m < 4; ++m) _Pragma("unroll") for (int k = 0; k < 2; ++k) dst[m][k] = *(const LAS bf16x8*)(lds + PG8_SA(b, h) + aoff + m * 2048 + k * 1024); } while (0)
#define PG8_LDB(dst, b, h) do { _Pragma("unroll") for (int n = 0; n < 2; ++n) _Pragma("unroll") for (int k = 0; k < 2; ++k) dst[n][k] = *(const LAS bf16x8*)(lds + PG8_SB(b, h) + boff + n * 2048 + k * 1024); } while (0)
#define PG8_MMA(ai, bj, At, Bt) do { __builtin_amdgcn_s_setprio(1); _Pragma("unroll") for (int m = 0; m < 4; ++m) _Pragma("unroll") for (int n = 0; n < 2; ++n) _Pragma("unroll") for (int k = 0; k < 2; ++k) \
        acc[ai][bj][m][n] = __builtin_amdgcn_mfma_f32_16x16x32_bf16(Bt[n][k], At[m][k], acc[ai][bj][m][n], 0, 0, 0); __builtin_amdgcn_s_setprio(0); } while (0)
#define PG8_WAIT_V(n) asm volatile("s_waitcnt vmcnt(" #n ")" ::: "memory")
#define PG8_WAIT_L(n) asm volatile("s_waitcnt lgkmcnt(" #n ")" ::: "memory")
#define PG8_BAR __builtin_amdgcn_s_barrier()
#define PG8_SCHED __builtin_amdgcn_sched_barrier(0)
    Unit cur, nxt; int ui = 0;
    if (!S.next(0, cur)) return;
    f32x4 acc[2][2][4][2];
#pragma unroll
    for (int a = 0; a < 2; ++a)
#pragma unroll
        for (int b = 0; b < 2; ++b)
#pragma unroll
            for (int m = 0; m < 4; ++m)
#pragma unroll
                for (int n = 0; n < 2; ++n) acc[a][b][m][n] = (f32x4){0.f, 0.f, 0.f, 0.f};
    bf16x8 At[4][2], B0[2][2], B1[2][2];
    const char* cA = (const char*)(g.A + cur.aoff); const char* cB = (const char*)(g.Bt + cur.boff);
    PG8_STAGE(PG8_SB(0, 0), cB, voffB); PG8_STAGE(PG8_SB(0, 1), cB + hstepB, voffB); PG8_STAGE(PG8_SA(0, 0), cA, voffA); PG8_STAGE(PG8_SA(0, 1), cA + hstepA, voffA);
    if (wr == 1) PG8_BAR;
    PG8_WAIT_V(2); PG8_BAR;
    PG8_STAGE(PG8_SB(1, 0), cB + kstep, voffB); PG8_STAGE(PG8_SA(1, 0), cA + kstep, voffA); PG8_STAGE(PG8_SB(1, 1), cB + hstepB + kstep, voffB);
    PG8_WAIT_V(6); PG8_BAR;
    for (;;) {
        const bool has_next = S.next(ui + 1, nxt);
        const char* nA = has_next ? (const char*)(g.A + nxt.aoff) : cA; const char* nB = has_next ? (const char*)(g.Bt + nxt.boff) : cB;
        for (int t = 0; t < nt; t += 2) {
            const bool last = (t == nt - 2);
            const char* a1 = cA + (size_t)(t + 1) * kstep;
            const char* a2 = last ? nA : cA + (size_t)(t + 2) * kstep; const char* b2 = last ? nB : cB + (size_t)(t + 2) * kstep;
            const char* a3 = a2 + kstep; const char* b3 = b2 + kstep;
            PG8_LDB(B0, 0, 0); PG8_LDB(B1, 0, 1); PG8_SCHED; PG8_LDA(At, 0, 0); PG8_STAGE(PG8_SA(1, 1), a1 + hstepA, voffA);
            PG8_WAIT_V(8); PG8_WAIT_L(0); PG8_BAR; PG8_MMA(0, 0, At, B0); PG8_MMA(0, 1, At, B1); PG8_BAR; PG8_SCHED;
            PG8_LDA(At, 0, 1); PG8_STAGE(PG8_SB(0, 0), b2, voffB); PG8_STAGE(PG8_SB(0, 1), b2 + hstepB, voffB); PG8_STAGE(PG8_SA(0, 0), a2, voffA);
            PG8_WAIT_V(8); PG8_WAIT_L(0); PG8_BAR; PG8_MMA(1, 0, At, B0); PG8_MMA(1, 1, At, B1); PG8_BAR; PG8_SCHED;
            PG8_LDB(B0, 1, 0); PG8_LDB(B1, 1, 1); PG8_SCHED; PG8_LDA(At, 1, 0); PG8_STAGE(PG8_SA(0, 1), a2 + hstepA, voffA);
            PG8_WAIT_V(8); PG8_WAIT_L(0); PG8_BAR; PG8_MMA(0, 0, At, B0); PG8_MMA(0, 1, At, B1); PG8_BAR; PG8_SCHED;
            PG8_LDA(At, 1, 1); PG8_STAGE(PG8_SB(1, 0), b3, voffB); PG8_STAGE(PG8_SB(1, 1), b3 + hstepB, voffB); PG8_STAGE(PG8_SA(1, 0), a3, voffA);
            PG8_WAIT_V(8); PG8_WAIT_L(0); PG8_BAR; PG8_MMA(1, 0, At, B0); PG8_MMA(1, 1, At, B1); PG8_BAR; PG8_SCHED;
        }
        if (wr == 0) PG8_BAR;
        { int fr_e = fr, fq_e = fq, wr_e = wr, wc_e = wc; asm volatile("" : "+v"(fr_e), "+v"(fq_e), "+s"(wr_e), "+s"(wc_e));
          E(acc, cur, wr_e, wc_e, fr_e, fq_e, lds); }
        if (!has_next) break;
#pragma unroll
        for (int a = 0; a < 2; ++a)
#pragma unroll
            for (int b = 0; b < 2; ++b)
#pragma unroll
                for (int m = 0; m < 4; ++m)
#pragma unroll
                    for (int n = 0; n < 2; ++n) acc[a][b][m][n] = (f32x4){0.f, 0.f, 0.f, 0.f};
        cur = nxt; cA = nA; cB = nB; ++ui;
        if (wr == 1) PG8_BAR;
    }
    PG8_WAIT_V(0);
    PG8_BAR;
#undef PG8_SA
#undef PG8_SB
#undef PG8_STAGE
#undef PG8_LDA
#undef PG8_LDB
#undef PG8_MMA
#undef PG8_WAIT_V
#undef PG8_WAIT_L
#undef PG8_SCHED
}

constexpr int EPI_LDS_OFF = 135168;

struct EpiSwiGLU {
    static constexpr bool PERM = true;
    bf16_t* H; int ldh;
    __device__ __forceinline__ void operator()(const f32x4 (&acc)[2][2][4][2], const Unit& u, int wr, int wc, int fr, int fq, LAS unsigned char*) const {
        bf16_t* base = H + u.coff + (size_t)(wr * 64 + fr) * ldh + wc * 32 + 8 * fq;
#pragma unroll
        for (int ai = 0; ai < 2; ++ai)
#pragma unroll
            for (int m = 0; m < 4; ++m) {
                const f32x4 g0 = acc[ai][0][m][0], g1 = acc[ai][0][m][1], u0 = acc[ai][1][m][0], u1 = acc[ai][1][m][1];
                float h[8];
#pragma unroll
                for (int i = 0; i < 4; ++i) { h[i] = siluf_(g0[i]) * u0[i]; h[4 + i] = siluf_(g1[i]) * u1[i]; }
                u32x4 w; w.x = cvt_pk_bf16(h[0], h[1]); w.y = cvt_pk_bf16(h[2], h[3]); w.z = cvt_pk_bf16(h[4], h[5]); w.w = cvt_pk_bf16(h[6], h[7]);
                *(u32x4*)(base + (size_t)(ai * HALF + m * 16) * ldh) = w;
            }
    }
};
struct EpiRes {
    static constexpr bool PERM = false;
    const float* X; float* Y; float s;
    __device__ __forceinline__ void operator()(const f32x4 (&acc)[2][2][4][2], const Unit& u, int wr, int wc, int fr, int fq, LAS unsigned char*) const {
        const size_t o0 = u.coff + (size_t)(wr * 64 + fr) * D + wc * 32 + 4 * fq;
#pragma unroll
        for (int ai = 0; ai < 2; ++ai)
#pragma unroll
            for (int m = 0; m < 4; ++m) { const size_t off = o0 + (size_t)(ai * HALF + m * 16) * D;
#pragma unroll
                for (int bj = 0; bj < 2; ++bj)
#pragma unroll
                    for (int n = 0; n < 2; ++n) { const f32x4 x = *(const f32x4*)(X + off + bj * HALF + n * 16); *(f32x4*)(Y + off + bj * HALF + n * 16) = x * ALPHA + acc[ai][bj][m][n] * s; } }
    }
};
struct EpiBf16 {
    static constexpr bool PERM = true;
    bf16_t* O; int ldc; float scale; float* G; int gate_tile;
    __device__ __forceinline__ void operator()(const f32x4 (&acc)[2][2][4][2], const Unit& u, int wr, int wc, int fr, int fq, LAS unsigned char*) const {
        bf16_t* base = O + u.coff + (size_t)(wr * 64 + fr) * ldc + wc * 32 + 8 * fq;
#pragma unroll
        for (int ai = 0; ai < 2; ++ai)
#pragma unroll
            for (int m = 0; m < 4; ++m) { bf16_t* rowp = base + (size_t)(ai * HALF + m * 16) * ldc;
#pragma unroll
                for (int bj = 0; bj < 2; ++bj) { const f32x4 v0 = acc[ai][bj][m][0] * scale, v1 = acc[ai][bj][m][1] * scale;
                    u32x4 w; w.x = cvt_pk_bf16(v0[0], v0[1]); w.y = cvt_pk_bf16(v0[2], v0[3]); w.z = cvt_pk_bf16(v1[0], v1[1]); w.w = cvt_pk_bf16(v1[2], v1[3]);
                    *(u32x4*)(rowp + bj * HALF) = w; } }
        if (G != nullptr && u.pn == gate_tile && wc == 0) {
#pragma unroll
            for (int ai = 0; ai < 2; ++ai)
#pragma unroll
                for (int m = 0; m < 4; ++m) { float* gp = G + (size_t)(u.pm * BM + ai * HALF + wr * 64 + m * 16 + fr) * 32 + 8 * fq;
                    *(f32x4*)(gp) = acc[ai][0][m][0]; *(f32x4*)(gp + 4) = acc[ai][0][m][1]; }
        }
    }
};
struct EpiSoftmax {
    static constexpr bool PERM = true;
    bf16_t* P; int ldc;
    __device__ __forceinline__ void operator()(f32x4 (&acc)[2][2][4][2], const Unit& u, int wr, int wc, int fr, int fq, LAS unsigned char* lds) const {
        LAS float* smax = (LAS float*)(lds + EPI_LDS_OFF); LAS float* ssum = smax + 1024;
#pragma unroll
        for (int ai = 0; ai < 2; ++ai)
#pragma unroll
            for (int m = 0; m < 4; ++m) { float mx = -3.0e38f;
#pragma unroll
                for (int bj = 0; bj < 2; ++bj)
#pragma unroll
                    for (int n = 0; n < 2; ++n) { const f32x4 x = acc[ai][bj][m][n]; mx = fmaxf(mx, fmaxf(fmaxf(x[0], x[1]), fmaxf(x[2], x[3]))); }
                mx = fmaxf(mx, shx(mx, 16, fr + 16 * fq)); mx = fmaxf(mx, shx(mx, 32, fr + 16 * fq));
                if (fq == 0) smax[wc * 256 + ai * HALF + wr * 64 + m * 16 + fr] = mx; }
        asm volatile("s_waitcnt lgkmcnt(0)" ::: "memory"); PG8_BAR; asm volatile("" ::: "memory");
#pragma unroll
        for (int ai = 0; ai < 2; ++ai)
#pragma unroll
            for (int m = 0; m < 4; ++m) { const int r = ai * HALF + wr * 64 + m * 16 + fr;
                const float mx = fmaxf(fmaxf(smax[r], smax[256 + r]), fmaxf(smax[512 + r], smax[768 + r])); float s = 0.f;
#pragma unroll
                for (int bj = 0; bj < 2; ++bj)
#pragma unroll
                    for (int n = 0; n < 2; ++n) { f32x4 x = acc[ai][bj][m][n];
                        x[0] = fast_exp2(x[0] - mx); x[1] = fast_exp2(x[1] - mx); x[2] = fast_exp2(x[2] - mx); x[3] = fast_exp2(x[3] - mx);
                        s += (x[0] + x[1]) + (x[2] + x[3]); acc[ai][bj][m][n] = x; }
                s += shx(s, 16, fr + 16 * fq); s += shx(s, 32, fr + 16 * fq);
                if (fq == 0) ssum[wc * 256 + r] = s; }
        asm volatile("s_waitcnt lgkmcnt(0)" ::: "memory"); PG8_BAR; asm volatile("" ::: "memory");
        bf16_t* base = P + u.coff + (size_t)(wr * 64 + fr) * ldc + wc * 32 + 8 * fq;
#pragma unroll
        for (int ai = 0; ai < 2; ++ai)
#pragma unroll
            for (int m = 0; m < 4; ++m) { const int r = ai * HALF + wr * 64 + m * 16 + fr;
                const float inv = 1.0f / ((ssum[r] + ssum[256 + r]) + (ssum[512 + r] + ssum[768 + r]));
                bf16_t* rowp = base + (size_t)(ai * HALF + m * 16) * ldc;
#pragma unroll
                for (int bj = 0; bj < 2; ++bj) { const f32x4 v0 = acc[ai][bj][m][0] * inv, v1 = acc[ai][bj][m][1] * inv;
                    u32x4 w; w.x = cvt_pk_bf16(v0[0], v0[1]); w.y = cvt_pk_bf16(v0[2], v0[3]); w.z = cvt_pk_bf16(v1[0], v1[1]); w.w = cvt_pk_bf16(v1[2], v1[3]);
                    *(u32x4*)(rowp + bj * HALF) = w; } }
    }
};
#undef PG8_BAR
}

constexpr size_t MiB = 1u << 20;
constexpr size_t SZ_WFI = (size_t)2 * DFF * D * 2, SZ_WFO = (size_t)D * DFF * 2, SZ_WMI = (size_t)NPROJ * D * 2, SZ_WDD = (size_t)D * D * 2, SZ_WKV = (size_t)2 * D * D * 2;
constexpr size_t WS_CTL = 0, CTL_ZERO_BYTES = 1 * MiB;
constexpr size_t WS_WFI = 2 * MiB;
constexpr size_t WS_WFO = WS_WFI + 4 * SZ_WFI;
constexpr size_t WS_WMI = WS_WFO + 4 * SZ_WFO;
constexpr size_t WS_WMO = WS_WMI + 2 * SZ_WMI;
constexpr size_t WS_WXQ = WS_WMO + 2 * SZ_WDD;
constexpr size_t WS_WXKV = WS_WXQ + 2 * SZ_WDD;
constexpr size_t WS_WXO = WS_WXKV + 2 * SZ_WKV;
constexpr size_t WS_XB = WS_WXO + 2 * SZ_WDD;
constexpr size_t WS_MEMB = WS_XB + (size_t)M * D * 2;
constexpr size_t WS_KB = WS_MEMB + (size_t)BATCH * NMEM * D * 2;
constexpr size_t WS_VT = WS_KB + (size_t)DEPTH * BATCH * NMEM * D * 2;
constexpr size_t WS_GATES = WS_VT + (size_t)DEPTH * BATCH * NMEM * D * 2;
constexpr size_t WS_MIXED = WS_GATES + (size_t)M * 32 * 4;
constexpr size_t WS_UNION = WS_MIXED + (size_t)M * D * 2;
constexpr size_t WS_END = WS_UNION + (size_t)M * NPROJ * 2;
constexpr size_t UN_Q = 0, UN_P = (size_t)M * D * 2, UN_O = UN_P + (size_t)M * 1024 * 2;
static_assert(WS_END < (size_t)1400 * MiB, "workspace map");
constexpr int CW_TMO = 0, CW_BAR = 4096, CW_WQ = 16384;

constexpr int LDS_BYTES = 163840;
constexpr int RING_BYTES = 131072, LDSCTL_OFF = LDS_BYTES - 512, MISC_OFF = LDSCTL_OFF + 320;
constexpr int NWAVES = 8;

#define RLX_AGENT __ATOMIC_RELAXED, __HIP_MEMORY_SCOPE_AGENT
#define LDS_WAIT() asm volatile("s_waitcnt lgkmcnt(0)" ::: "memory")
#define VM_WAIT() asm volatile("s_waitcnt vmcnt(0)" ::: "memory")

#define XB_TMO      128
#define XB_XCNT(j)  (256  + 64 * (j))
#define XB_XSUB(j)  (1280 + 64 * (j))
#define XB_XGEN(j)  (2304 + 64 * (j))
#define XB_TOP      3328
#define XB_TOPGEN   3392
#define XCD_BAR_WORDS 3456
#define XB_SPIN_CAP (1u << 20)
__device__ __forceinline__ unsigned xb_ld(unsigned* p)              { return __hip_atomic_load(p, __ATOMIC_RELAXED, __HIP_MEMORY_SCOPE_AGENT); }
__device__ __forceinline__ unsigned xb_add(unsigned* p, unsigned v) { return __hip_atomic_fetch_add(p, v, __ATOMIC_RELAXED, __HIP_MEMORY_SCOPE_AGENT); }
__device__ __forceinline__ unsigned xb_xcc_id() { return (unsigned)__builtin_amdgcn_s_getreg((3 << 11) | 20) & 0xFu; }
#define XB_SPIN(cond, bar) do { unsigned _sp = 0; while (cond) { __builtin_amdgcn_s_sleep(1); \
    if ((++_sp & 255u) == 0u) { if (xb_ld(&(bar)[XB_TMO])) break; if (_sp > XB_SPIN_CAP) { atomicAdd(&(bar)[XB_TMO], 1u); break; } } } } while (0)
struct XcdBarrier { unsigned* bar; unsigned x; volatile LAS unsigned* st; };
__device__ __forceinline__ XcdBarrier xcd_barrier_post(unsigned* bar, volatile LAS unsigned* st) {
    XcdBarrier b; b.bar = bar; b.x = xb_xcc_id(); b.st = st;
    if (threadIdx.x == 0) (void)xb_add(&bar[XB_XCNT(b.x)], 1u);
    return b;
}
__device__ __forceinline__ void xcd_barrier_complete(unsigned* bar, unsigned x, unsigned& nloc, unsigned& nx) {
    const unsigned G = gridDim.x * gridDim.y * gridDim.z;
    unsigned sum, cnt, mine, sp = 0u;
    for (;;) {
        sum = 0u; cnt = 0u; mine = 0u;
#pragma unroll
        for (unsigned j = 0; j < 16; ++j) { const unsigned c = xb_ld(&bar[XB_XCNT(j)]); sum += c; cnt += (c > 0u) ? 1u : 0u; mine = (j == x) ? c : mine; }
        if (sum == G) break;
        __builtin_amdgcn_s_sleep(1);
        if ((++sp & 255u) == 0u) { if (xb_ld(&bar[XB_TMO])) break; if (sp > XB_SPIN_CAP) { atomicAdd(&bar[XB_TMO], 1u); break; } }
    }
    nloc = mine > 0u ? mine : 1u; nx = cnt > 0u ? cnt : 1u;
}
__device__ __forceinline__ void xcd_barrier(const XcdBarrier& b) {
    asm volatile("s_waitcnt vmcnt(0)" ::: "memory");
    __syncthreads();
    if (threadIdx.x == 0) {
        unsigned* bar = b.bar; asm volatile("" : "+s"(bar));
        __builtin_amdgcn_s_waitcnt(0);
        unsigned nloc = b.st[0], nx = b.st[1];
        if (nloc == 0u) { xcd_barrier_complete(bar, b.x, nloc, nx); b.st[0] = nloc; b.st[1] = nx; }
        const unsigned old = xb_add(&bar[XB_XSUB(b.x)], 1u);
        const unsigned gen = old / nloc;
        if (old + 1u == (gen + 1u) * nloc) {
            __builtin_amdgcn_fence(__ATOMIC_RELEASE, "agent");
            asm volatile("s_waitcnt vmcnt(0)" ::: "memory");
            const unsigned og = xb_add(&bar[XB_TOP], 1u);
            const unsigned tg = og / nx;
            if (og + 1u == (tg + 1u) * nx) xb_add(&bar[XB_TOPGEN], 1u);
            else XB_SPIN(xb_ld(&bar[XB_TOPGEN]) == tg, bar);
            __builtin_amdgcn_fence(__ATOMIC_ACQUIRE, "agent");
            xb_add(&bar[XB_XGEN(b.x)], 1u);
            asm volatile("s_waitcnt vmcnt(0)" ::: "memory");
        } else {
            XB_SPIN(xb_ld(&bar[XB_XGEN(b.x)]) == gen, bar);
            __builtin_amdgcn_fence(__ATOMIC_ACQUIRE, "agent");
            asm volatile("s_waitcnt vmcnt(0)" ::: "memory");
        }
    }
    __syncthreads();
}

__device__ __forceinline__ float wave_sum(float v, int lane) {
#pragma unroll
    for (int o = 1; o < 64; o <<= 1) v += shx(v, o, lane);
    return v;
}
struct MapId { __device__ __forceinline__ int operator()(int d) const { return d; } };
struct MapFfnIn { __device__ __forceinline__ int operator()(int d) const { const int blk = d >> 8, r = d & 255, j = blk * 128 + (r & 127); return (r < 128) ? j : DFF + j; } };
struct MapMixIn { __device__ __forceinline__ int operator()(int d) const {
    if (d < 1024) return d; if (d < 6144) return d + 16; if (d < 6656) return d + 24; if (d < 6672) return 1024 + (d - 6656); if (d < 6680) return 6160 + (d - 6672); return -1; } };
template <class CM>
__device__ __forceinline__ void transpose_item(const float* W, int K, int Nsrc, bf16_t* WT, LAS float* scr, int kb, int nb, int lane, const CM cm) {
    const int k0 = 64 * kb, n0 = 32 * nb; const int sc = cm(n0 + (lane & 31));
#pragma unroll 8
    for (int i = 0; i < 32; ++i) { const int kk = 2 * i + (lane >> 5); scr[kk * 33 + (lane & 31)] = (sc >= 0) ? W[(size_t)(k0 + kk) * Nsrc + sc] : 0.f; }
    LDS_WAIT(); asm volatile("" ::: "memory");
    const int c = lane & 7;
#pragma unroll
    for (int j = 0; j < 4; ++j) { const int n = (lane >> 3) + 8 * j; const LAS float* s = scr + (8 * c) * 33 + n;
        u32x4 o; o.x = cvt_pk_bf16(s[0 * 33], s[1 * 33]); o.y = cvt_pk_bf16(s[2 * 33], s[3 * 33]); o.z = cvt_pk_bf16(s[4 * 33], s[5 * 33]); o.w = cvt_pk_bf16(s[6 * 33], s[7 * 33]);
        *(u32x4*)(WT + (size_t)(n0 + n) * K + k0 + 8 * c) = o; }
    LDS_WAIT(); asm volatile("" ::: "memory");
}
template <class CM>
__device__ __forceinline__ void transpose_matrix(const float* W, int K, int Nsrc, int Ndst, bf16_t* WT, LAS float* scr, int gw, int NGW, const CM cm) {
    const int lane = lane_id();
    const int nblk = Ndst / 32, items = (K / 64) * nblk;
    for (int it = gw; it < items; it += NGW) transpose_item(W, K, Nsrc, WT, scr, it / nblk, it % nblk, lane, cm);
}
__device__ __forceinline__ void cvt_copy(const float* src, bf16_t* dst, size_t n, size_t gt, size_t NGT) {
    for (size_t i = gt * 8; i < n; i += NGT * 8) { const f32x4 a = *(const f32x4*)(src + i), b = *(const f32x4*)(src + i + 4);
        u32x4 w; w.x = cvt_pk_bf16(a[0], a[1]); w.y = cvt_pk_bf16(a[2], a[3]); w.z = cvt_pk_bf16(b[0], b[1]); w.w = cvt_pk_bf16(b[2], b[3]); *(u32x4*)(dst + i) = w; }
}
__device__ __forceinline__ void ln_phase(float* Y, bf16_t* XB, const float* g, const float* b, int gw, int NGW) {
    const int lane = lane_id();
    f32x4 gv[8], bv[8];
#pragma unroll
    for (int j = 0; j < 8; ++j) { gv[j] = *(const f32x4*)(g + 4 * lane + 256 * j); bv[j] = *(const f32x4*)(b + 4 * lane + 256 * j); }
    for (int m = gw; m < M; m += NGW) {
        float* yr = Y + (size_t)m * D + 4 * lane; f32x4 v[8]; float s = 0.f;
#pragma unroll
        for (int j = 0; j < 8; ++j) { v[j] = *(const f32x4*)(yr + 256 * j); s += (v[j][0] + v[j][1]) + (v[j][2] + v[j][3]); }
        const float mean = wave_sum(s, lane) * (1.f / D); float s2 = 0.f;
#pragma unroll
        for (int j = 0; j < 8; ++j) { v[j] = v[j] - mean; s2 += (v[j][0] * v[j][0] + v[j][1] * v[j][1]) + (v[j][2] * v[j][2] + v[j][3] * v[j][3]); }
        const float rstd = 1.f / sqrtf(wave_sum(s2, lane) * (1.f / D) + LN_EPS);
        bf16_t* xr = XB + (size_t)m * D + 4 * lane;
#pragma unroll
        for (int j = 0; j < 8; ++j) { const f32x4 o = v[j] * rstd * gv[j] + bv[j]; *(f32x4*)(yr + 256 * j) = o;
            u32x2 w; w.x = cvt_pk_bf16(o[0], o[1]); w.y = cvt_pk_bf16(o[2], o[3]); *(u32x2*)(xr + 256 * j) = w; }
    }
}
struct XsOrder { int G, c;
    __device__ bool next(int i, pg8::Unit& u) const { const int L = i * G + c; if (L >= 512) return false; const int pml = L & 31, bh = L >> 5, b = bh >> 2, h = bh & 3;
        u.pm = L; u.pn = 0; u.aoff = (unsigned)(b * SEQ + pml * 256) * D + h * 512; u.boff = (unsigned)(b * NMEM) * D + h * 512; u.coff = (unsigned)(b * SEQ + pml * 256) * 1024 + h * 256; return true; } };
struct XpvOrder { int G, c;
    __device__ bool next(int i, pg8::Unit& u) const { const int L = i * G + c; if (L >= 1024) return false; const int pn = L & 1, pml = (L >> 1) & 31, bh = L >> 6, b = bh >> 2, h = bh & 3;
        u.pm = L; u.pn = pn; u.aoff = (unsigned)(b * SEQ + pml * 256) * 1024 + h * 256; u.boff = (unsigned)(h * 512 + pn * 256) * 1024 + b * NMEM; u.coff = (unsigned)(b * SEQ + pml * 256) * D + h * 512 + pn * 256; return true; } };

struct Args { const float* in[21]; float* out; unsigned char* ws; };
enum { I_X = 0, I_MEM, I_LNG, I_LNB, I_FWI, I_FWO, I_WIN, I_WOUT, I_GGW, I_GGB, I_GNG, I_HLB, I_HNG, I_DLAM, I_DNG, I_T5, I_MCW, I_MGB, I_XWQ, I_XWKV, I_XWO };

struct Ctx {
    LAS unsigned char* lds; int wave, G, bx, gw, NGW; unsigned* ctl; unsigned char* ws; float* out;
};

#define GRID_BAR() xcd_barrier(bar)
typedef __attribute__((address_space(4))) const Args* KArgsP;
__device__ __forceinline__ KArgsP kargs() { KArgsP p = (KArgsP)__builtin_amdgcn_kernarg_segment_ptr(); asm volatile("" : "+s"(p)); return p; }
#define ARG_IN(i) (kargs()->in[i])
#define ARG_OUT() (kargs()->out)
__device__ __forceinline__ int opq(int x) { asm volatile("" : "+s"(x)); return x; }

namespace mix {
constexpr int PJ = 72;
__device__ __forceinline__ f32x4 mma16(const LAS bf16_t* A, int lda, const LAS bf16_t* Bt, int ldb, int K, f32x4 acc, int lane) {
    const LAS bf16_t* ap = A + (lane & 15) * lda + 8 * (lane >> 4); const LAS bf16_t* bp = Bt + (lane & 15) * ldb + 8 * (lane >> 4);
    for (int k0 = 0; k0 < K; k0 += 32) { const bf16x8 a = *(const LAS bf16x8*)(ap + k0), b = *(const LAS bf16x8*)(bp + k0); acc = __builtin_amdgcn_mfma_f32_16x16x32_bf16(b, a, acc, 0, 0, 0); }
    return acc;
}
__device__ __forceinline__ float lane_prefix_sum(float x, int lane) {
#pragma unroll
    for (int o = 1; o < 64; o <<= 1) { const float t = __int_as_float(__builtin_amdgcn_ds_bpermute(((lane - o) & 63) << 2, __float_as_int(x))); if (lane >= o) x += t; }
    return x;
}
__device__ __forceinline__ float lane_prefix_max(float x, int lane) {
#pragma unroll
    for (int o = 1; o < 64; o <<= 1) { const float t = __int_as_float(__builtin_amdgcn_ds_bpermute(((lane - o) & 63) << 2, __float_as_int(x))); if (lane >= o) x = fmaxf(x, t); }
    return x;
}
__device__ __forceinline__ float rdlane(float x, int l) { return __int_as_float(__builtin_amdgcn_readlane(__float_as_int(x), l)); }
__device__ __forceinline__ float wsum(float v, int lane) {
#pragma unroll
    for (int o = 1; o < 64; o <<= 1) v += shx(v, o, lane);
    return v;
}
__device__ __forceinline__ float expc(float x) { return fast_exp(fminf(x, 80.f)); }
#define MIX_BAR() do { asm volatile("s_waitcnt vmcnt(0) lgkmcnt(0)" ::: "memory"); __builtin_amdgcn_s_barrier(); asm volatile("" ::: "memory"); } while (0)
#define MIX_LBAR() do { asm volatile("s_waitcnt lgkmcnt(0)" ::: "memory"); __builtin_amdgcn_s_barrier(); asm volatile("" ::: "memory"); } while (0)

template <int DK, bool HGRN>
__device__ __forceinline__ void gla_stream(LAS unsigned char* lds, int wave, int lane, const bf16_t* PROJ, const float* GATES, bf16_t* MIXED, int b, int h,
                                           const float* gate_w, const float* gate_b, const float* hlb0, const float* hlb1, int layer, const float* norm_g) {
    constexpr int P = DK + 8, CH = DK / 8, NQ = CH / 8, ND = DK / 16;
    LAS bf16_t* qa = (LAS bf16_t*)lds;
    LAS bf16_t* qb = qa + 64 * P;
    LAS bf16_t* ka = qb + 32 * P;
    LAS bf16_t* kb = ka + 32 * P;
    LAS bf16_t* ksT = kb + 64 * P;
    LAS bf16_t* vT = ksT + DK * PJ;
    LAS bf16_t* ST = vT + 128 * PJ;
    LAS bf16_t* at = ST + 128 * P;
    LAS float* dec = (LAS float*)(at + 64 * PJ);
    LAS float* rsum = dec + DK;
    LAS float* wg = rsum + 512;
    static_assert((size_t)((64 + 32 + 32 + 64 + 128) * P + (DK + 128 + 64) * PJ) * 2 + (DK + 512 + 1100) * 4 <= 160 * 1024 - 1024, "stream LDS map");
    const int tid = wave * 64 + lane, d0 = wave * CH, fq = lane >> 4, fr = lane & 15;
    if (HGRN) { for (int i = tid; i < DK; i += 512) { const int c = h * DK + i; float lbv = 0.f; if (layer == 1) { lbv = sigmoidf_(hlb1[c] - hlb0[c]); lbv = fminf(fmaxf(lbv, 0.f), 1.f - 1e-6f); } wg[i] = lbv; } }
    else { for (int i = tid; i < 16 * 64; i += 512) wg[i] = gate_w[(i >> 6) * 256 + h * 64 + (i & 63)]; for (int i = tid; i < 64; i += 512) wg[1024 + i] = gate_b[h * 64 + i]; }
    for (int i = tid; i < 128 * P / 2; i += 512) ((LAS unsigned*)ST)[i] = 0u;
    f32x4 sacc[ND];
#pragma unroll
    for (int i = 0; i < ND; ++i) sacc[i] = (f32x4){0.f, 0.f, 0.f, 0.f};
    const f32x4 ng = *(const f32x4*)(norm_g + 16 * wave + 4 * fq);
    const int qcol = HGRN ? PQ_B + h * 128 + d0 : PQ_A + h * 64 + d0, kcol = HGRN ? PF_B + h * 128 + d0 : PK_A + h * 64 + d0;
    const int vcol = (HGRN ? PI_B : PV_A) + h * 128 + 16 * wave, gcol = (HGRN ? PG_B : PR_A) + h * 128 + 16 * wave + 4 * fq, ocol = (HGRN ? 512 : 0) + h * 128 + 16 * wave + 4 * fq;
    const size_t row0 = (size_t)b * SEQ;
    u32x4 rq[NQ], rk[NQ], rv[2]; f32x4 rl[4];
#define GLA_LOAD(c) do { const bf16_t* pr = PROJ + (row0 + (size_t)(c) * 64 + lane) * NPROJ; \
        _Pragma("unroll") for (int i_ = 0; i_ < NQ; ++i_) { rq[i_] = *(const u32x4*)(pr + qcol + 8 * i_); rk[i_] = *(const u32x4*)(pr + kcol + 8 * i_); } \
        rv[0] = *(const u32x4*)(pr + vcol); rv[1] = *(const u32x4*)(pr + vcol + 8); \
        if (!HGRN) { const float* pg = GATES + (row0 + (size_t)(c) * 64 + lane) * 32; _Pragma("unroll") for (int i_ = 0; i_ < 4; ++i_) rl[i_] = *(const f32x4*)(pg + 4 * i_); } } while (0)
    GLA_LOAD(0);
    MIX_BAR();
    for (int c = 0; c < SEQ / 64; ++c) {
        {
            float qv[CH], kv[CH], cum[CH];
#pragma unroll
            for (int i = 0; i < CH; ++i) {
                const unsigned wq = rq[i >> 3][(i >> 1) & 3], wk = rk[i >> 3][(i >> 1) & 3];
                const float qraw = (i & 1) ? bfhi(wq) : bflo(wq), kraw = (i & 1) ? bfhi(wk) : bflo(wk);
                float g;
                if (HGRN) { const float lbv = wg[d0 + i]; const float sg = sigmoidf_(kraw); g = __logf(fmaxf(lbv, 1e-12f) + (1.f - lbv) * sg); qv[i] = siluf_(qraw) * 0.08838834764831845f; kv[i] = (1.f - lbv) * (1.f - sg); }
                else { float a = wg[1024 + d0 + i];
#pragma unroll
                    for (int r = 0; r < 16; ++r) a += rl[r >> 2][r & 3] * wg[r * 64 + d0 + i];
                    g = logsigmoidf_(a) * 0.0625f; qv[i] = qraw * 0.125f; kv[i] = kraw; }
                cum[i] = lane_prefix_sum(g, lane);
            }
            unsigned pqa[CH / 2], pqb[CH / 2], pka[CH / 2], pkb[CH / 2];
#pragma unroll
            for (int i = 0; i < CH; i += 2) {
                float e0[2], eb[2], ea[2], ek[2], es[2];
#pragma unroll
                for (int j = 0; j < 2; ++j) { const float cm = cum[i + j], c31 = rdlane(cm, 31), c63 = rdlane(cm, 63);
                    e0[j] = qv[i + j] * expc(cm); eb[j] = qv[i + j] * expc(cm - c31); ea[j] = kv[i + j] * expc(-cm); ek[j] = kv[i + j] * expc(c31 - cm); es[j] = kv[i + j] * expc(c63 - cm);
                    if (lane == 63) dec[d0 + i + j] = expc(c63);
                    ksT[(d0 + i + j) * PJ + lane] = f2bf(es[j]); }
                pqa[i >> 1] = cvt_pk_bf16_c(e0[0], e0[1]); pqb[i >> 1] = cvt_pk_bf16_c(eb[0], eb[1]); pka[i >> 1] = cvt_pk_bf16_c(ea[0], ea[1]); pkb[i >> 1] = cvt_pk_bf16_c(ek[0], ek[1]);
            }
#pragma unroll
            for (int i = 0; i < NQ; ++i) {
                *(LAS u32x4*)(qa + lane * P + d0 + 8 * i) = (u32x4){pqa[4 * i], pqa[4 * i + 1], pqa[4 * i + 2], pqa[4 * i + 3]};
                *(LAS u32x4*)(kb + lane * P + d0 + 8 * i) = (u32x4){pkb[4 * i], pkb[4 * i + 1], pkb[4 * i + 2], pkb[4 * i + 3]};
                if (lane >= 32) *(LAS u32x4*)(qb + (lane - 32) * P + d0 + 8 * i) = (u32x4){pqb[4 * i], pqb[4 * i + 1], pqb[4 * i + 2], pqb[4 * i + 3]};
                else *(LAS u32x4*)(ka + lane * P + d0 + 8 * i) = (u32x4){pka[4 * i], pka[4 * i + 1], pka[4 * i + 2], pka[4 * i + 3]};
            }
#pragma unroll
            for (int i = 0; i < 16; ++i) { const unsigned w = rv[i >> 3][(i >> 1) & 3]; vT[(16 * wave + i) * PJ + lane] = (bf16_t)((i & 1) ? (w >> 16) : (w & 0xffffu)); }
        }
        if (c + 1 < SEQ / 64) GLA_LOAD(c + 1);
        u32x2 gt[4];
#pragma unroll
        for (int tt = 0; tt < 4; ++tt) gt[tt] = *(const u32x2*)(PROJ + (row0 + (size_t)c * 64 + 16 * tt + fr) * NPROJ + gcol);
        MIX_LBAR();
        {
            const int ti = wave >> 1;
#pragma unroll
            for (int j = 0; j < 2; ++j) { const int tj = 2 * (wave & 1) + j; f32x4 a = (f32x4){0.f, 0.f, 0.f, 0.f};
                if (tj <= ti) { a = (ti < 2) ? mma16(qa + 16 * ti * P, P, ka + 16 * tj * P, P, DK, a, lane) : mma16(qb + 16 * (ti - 2) * P, P, kb + 16 * tj * P, P, DK, a, lane);
                    if (tj == ti) {
#pragma unroll
                        for (int r = 0; r < 4; ++r) if (4 * fq + r > fr) a[r] = 0.f; } }
                u32x2 w; w.x = cvt_pk_bf16_c(a[0], a[1]); w.y = cvt_pk_bf16_c(a[2], a[3]); *(LAS u32x2*)(at + (16 * ti + fr) * PJ + 16 * tj + 4 * fq) = w; }
        }
        f32x4 oacc[4];
#pragma unroll
        for (int tt = 0; tt < 4; ++tt) oacc[tt] = mma16(qa + 16 * tt * P, P, ST + 16 * wave * P, P, DK, (f32x4){0.f, 0.f, 0.f, 0.f}, lane);
        MIX_LBAR();
#pragma unroll
        for (int tt = 0; tt < 4; ++tt) oacc[tt] = mma16(at + 16 * tt * PJ, PJ, vT + 16 * wave * PJ, PJ, tt < 2 ? 32 : 64, oacc[tt], lane);
#pragma unroll
        for (int dt = 0; dt < ND; ++dt) { const f32x4 dv = *(const LAS f32x4*)(dec + 16 * dt + 4 * fq);
            sacc[dt] = mma16(vT + 16 * wave * PJ, PJ, ksT + 16 * dt * PJ, PJ, 64, sacc[dt] * dv, lane);
            u32x2 w; w.x = cvt_pk_bf16_c(sacc[dt][0], sacc[dt][1]); w.y = cvt_pk_bf16_c(sacc[dt][2], sacc[dt][3]); *(LAS u32x2*)(ST + (16 * wave + fr) * P + 16 * dt + 4 * fq) = w; }
#pragma unroll
        for (int tt = 0; tt < 4; ++tt) { float s = (oacc[tt][0] * oacc[tt][0] + oacc[tt][1] * oacc[tt][1]) + (oacc[tt][2] * oacc[tt][2] + oacc[tt][3] * oacc[tt][3]);
            s += shx(s, 16, lane); s += shx(s, 32, lane); if (fq == 0) rsum[wave * 64 + 16 * tt + fr] = s; }
        MIX_LBAR();
#pragma unroll
        for (int tt = 0; tt < 4; ++tt) { float tot = 0.f;
#pragma unroll
            for (int w8 = 0; w8 < 8; ++w8) tot += rsum[w8 * 64 + 16 * tt + fr];
            const float rstd = 1.0f / sqrtf(tot * (1.f / 128.f) + LN_EPS);
            const float g0 = bflo(gt[tt].x), g1 = bfhi(gt[tt].x), g2 = bflo(gt[tt].y), g3 = bfhi(gt[tt].y);
            const f32x4 o = oacc[tt] * rstd * ng;
            u32x2 w; w.x = cvt_pk_bf16_c(o[0] * siluf_(g0), o[1] * siluf_(g1)); w.y = cvt_pk_bf16_c(o[2] * siluf_(g2), o[3] * siluf_(g3));
            *(u32x2*)(MIXED + (row0 + (size_t)c * 64 + 16 * tt + fr) * D + ocol) = w; }
    }
    MIX_BAR();
#undef GLA_LOAD
}

__device__ __forceinline__ void mlstm_stream(LAS unsigned char* lds, int wave, int lane, const bf16_t* PROJ, const float* GATES, bf16_t* MIXED, int b, int h, const float* conv_w, const float* gate_b) {
    LAS bf16_t* q_ = (LAS bf16_t*)lds;
    LAS bf16_t* qh = q_ + 64 * PJ;
    LAS bf16_t* k_ = qh + 64 * PJ;
    LAS bf16_t* ksT = k_ + 64 * PJ;
    LAS bf16_t* vT = ksT + 64 * PJ;
    LAS bf16_t* CT = vT + 128 * PJ;
    LAS bf16_t* sc = CT + 128 * PJ;
    LAS float* av = (LAS float*)(sc + 64 * PJ);
    LAS float* uv = av + 64;
    LAS float* mt = uv + 64;
    LAS float* nst = mt + 64;
    LAS float* qn = nst + 64;
    LAS float* rs = qn + 512;
    LAS float* cw = rs + 256;
    const int tid = wave * 64 + lane, d0 = wave * 8, fq = lane >> 4, fr = lane & 15;
    for (int i = tid; i < 512; i += 512) { const int part = i >> 8, j = (i >> 6) & 3, d = i & 63; cw[i] = conv_w[j * 512 + part * 256 + h * 64 + d]; }
    for (int i = tid; i < 64; i += 512) nst[i] = 0.f;
    for (int i = tid; i < 128 * PJ / 2; i += 512) ((LAS unsigned*)CT)[i] = 0u;
    const float bi = gate_b[h], bf = gate_b[4 + h];
    float m_st = 0.f;
    f32x4 cacc[4];
#pragma unroll
    for (int i = 0; i < 4; ++i) cacc[i] = (f32x4){0.f, 0.f, 0.f, 0.f};
    const size_t row0 = (size_t)b * SEQ;
    const int qcol = PQ_D + h * 64 + d0, kcol = PK_D + h * 64 + d0, vcol = PV_D + h * 128 + 16 * wave, gcol = PO_D + h * 128 + 16 * wave + 4 * fq, ocol = 1536 + h * 128 + 16 * wave + 4 * fq;
    u32x4 rq[4], rk[4], rv[2]; float gi, gf;
#define ML_LOAD(c) do { const int t_ = (c) * 64 + lane; \
        _Pragma("unroll") for (int j_ = 0; j_ < 4; ++j_) { if (t_ - j_ >= 0) { const bf16_t* pr = PROJ + (row0 + (size_t)(t_ - j_)) * NPROJ; rq[j_] = *(const u32x4*)(pr + qcol); rk[j_] = *(const u32x4*)(pr + kcol); } \
            else { rq[j_] = (u32x4){0u, 0u, 0u, 0u}; rk[j_] = (u32x4){0u, 0u, 0u, 0u}; } } \
        { const bf16_t* pr = PROJ + (row0 + (size_t)t_) * NPROJ; rv[0] = *(const u32x4*)(pr + vcol); rv[1] = *(const u32x4*)(pr + vcol + 8); const float* pg = GATES + (row0 + (size_t)t_) * 32; gi = pg[16 + h]; gf = pg[20 + h]; } } while (0)
    ML_LOAD(0);
    MIX_BAR();
    for (int c = 0; c < SEQ / 64; ++c) {
        float dec_c;
        {
            const float li = gi + bi, lf = logsigmoidf_(gf + bf);
            const float cum = lane_prefix_sum(lf, lane), a = li - cum, pm = lane_prefix_max(a, lane), u = fmaxf(m_st, pm);
            const float w_inter = fast_exp(m_st - u), u63 = rdlane(u, 63), cum63 = rdlane(cum, 63), wk = fast_exp(a - u63);
            dec_c = fast_exp(m_st - u63);
            if (wave == 0) { av[lane] = a; uv[lane] = u; mt[lane] = cum + u; }
            float qc[8], kc[8];
#pragma unroll
            for (int i = 0; i < 8; ++i) { float sq = 0.f, sk = 0.f;
#pragma unroll
                for (int j = 0; j < 4; ++j) { const unsigned wq = rq[j][i >> 1], wkk = rk[j][i >> 1]; const float xq = (i & 1) ? bfhi(wq) : bflo(wq), xk = (i & 1) ? bfhi(wkk) : bflo(wkk);
                    sq += cw[(3 - j) * 64 + d0 + i] * xq; sk += cw[256 + (3 - j) * 64 + d0 + i] * xk; }
                qc[i] = siluf_(sq); kc[i] = siluf_(sk) * 0.125f; }
            float qnp = 0.f; unsigned pq[4], ph[4], pk[4];
#pragma unroll
            for (int i = 0; i < 8; i += 2) { pq[i >> 1] = cvt_pk_bf16_c(qc[i], qc[i + 1]); ph[i >> 1] = cvt_pk_bf16_c(qc[i] * w_inter, qc[i + 1] * w_inter); pk[i >> 1] = cvt_pk_bf16_c(kc[i], kc[i + 1]); }
#pragma unroll
            for (int i = 0; i < 8; ++i) { const float nold = nst[d0 + i]; qnp += qc[i] * w_inter * nold; const float kw = kc[i] * wk; ksT[(d0 + i) * PJ + lane] = f2bf(kw);
                const float nsum = wsum(kw, lane); if (lane == 0) nst[d0 + i] = dec_c * nold + nsum; }
            qn[wave * 64 + lane] = qnp;
            *(LAS u32x4*)(q_ + lane * PJ + d0) = (u32x4){pq[0], pq[1], pq[2], pq[3]};
            *(LAS u32x4*)(qh + lane * PJ + d0) = (u32x4){ph[0], ph[1], ph[2], ph[3]};
            *(LAS u32x4*)(k_ + lane * PJ + d0) = (u32x4){pk[0], pk[1], pk[2], pk[3]};
#pragma unroll
            for (int i = 0; i < 16; ++i) { const unsigned w = rv[i >> 3][(i >> 1) & 3]; vT[(16 * wave + i) * PJ + lane] = (bf16_t)((i & 1) ? (w >> 16) : (w & 0xffffu)); }
            m_st = cum63 + u63;
        }
        if (c + 1 < SEQ / 64) ML_LOAD(c + 1);
        u32x2 gt[4];
#pragma unroll
        for (int tt = 0; tt < 4; ++tt) gt[tt] = *(const u32x2*)(PROJ + (row0 + (size_t)c * 64 + 16 * tt + fr) * NPROJ + gcol);
        MIX_LBAR();
        {
            const int ti = wave >> 1;
#pragma unroll
            for (int j = 0; j < 2; ++j) { const int tj = 2 * (wave & 1) + j; f32x4 a = (f32x4){0.f, 0.f, 0.f, 0.f};
                if (tj <= ti) { a = mma16(q_ + 16 * ti * PJ, PJ, k_ + 16 * tj * PJ, PJ, 64, a, lane);
                    const float ui = uv[16 * ti + fr]; const f32x4 aj = *(const LAS f32x4*)(av + 16 * tj + 4 * fq);
#pragma unroll
                    for (int r = 0; r < 4; ++r) a[r] = (16 * tj + 4 * fq + r <= 16 * ti + fr) ? a[r] * fast_exp(aj[r] - ui) : 0.f; }
                float s = (a[0] + a[1]) + (a[2] + a[3]); s += shx(s, 16, lane); s += shx(s, 32, lane); if (fq == 0) rs[tj * 64 + 16 * ti + fr] = s;
                u32x2 w; w.x = cvt_pk_bf16_c(a[0], a[1]); w.y = cvt_pk_bf16_c(a[2], a[3]); *(LAS u32x2*)(sc + (16 * ti + fr) * PJ + 16 * tj + 4 * fq) = w; }
        }
        f32x4 oacc[4];
#pragma unroll
        for (int tt = 0; tt < 4; ++tt) oacc[tt] = mma16(qh + 16 * tt * PJ, PJ, CT + 16 * wave * PJ, PJ, 64, (f32x4){0.f, 0.f, 0.f, 0.f}, lane);
        MIX_LBAR();
#pragma unroll
        for (int tt = 0; tt < 4; ++tt) oacc[tt] = mma16(sc + 16 * tt * PJ, PJ, vT + 16 * wave * PJ, PJ, tt < 2 ? 32 : 64, oacc[tt], lane);
#pragma unroll
        for (int dt = 0; dt < 4; ++dt) { cacc[dt] = mma16(vT + 16 * wave * PJ, PJ, ksT + 16 * dt * PJ, PJ, 64, cacc[dt] * dec_c, lane);
            u32x2 w; w.x = cvt_pk_bf16_c(cacc[dt][0], cacc[dt][1]); w.y = cvt_pk_bf16_c(cacc[dt][2], cacc[dt][3]); *(LAS u32x2*)(CT + (16 * wave + fr) * PJ + 16 * dt + 4 * fq) = w; }
#pragma unroll
        for (int tt = 0; tt < 4; ++tt) { const int i = 16 * tt + fr; float den = 0.f;
#pragma unroll
            for (int w8 = 0; w8 < 8; ++w8) den += qn[w8 * 64 + i];
            den += (rs[i] + rs[64 + i]) + (rs[128 + i] + rs[192 + i]);
            const float inv = 1.0f / fmaxf(fabsf(den), fast_exp(-mt[i]));
            const float g0 = bflo(gt[tt].x), g1 = bfhi(gt[tt].x), g2 = bflo(gt[tt].y), g3 = bfhi(gt[tt].y);
            u32x2 w; w.x = cvt_pk_bf16_c(oacc[tt][0] * inv * sigmoidf_(g0), oacc[tt][1] * inv * sigmoidf_(g1)); w.y = cvt_pk_bf16_c(oacc[tt][2] * inv * sigmoidf_(g2), oacc[tt][3] * inv * sigmoidf_(g3));
            *(u32x2*)(MIXED + (row0 + (size_t)c * 64 + i) * D + ocol) = w; }
        MIX_LBAR();
    }
    MIX_BAR();
#undef ML_LOAD
}

constexpr int KP = 136, VP = 160, KT_BYTES = 64 * KP * 2, VT_BYTES = 64 * VP * 2, AT_BUF = KT_BYTES + VT_BYTES;
__device__ __forceinline__ int crow(int r, int hi) { return (r & 3) + 8 * (r >> 2) + 4 * hi; }
__device__ __forceinline__ void diff_unit(LAS unsigned char* lds, int wave, int lane, const bf16_t* PROJ, bf16_t* MIXED, int b, int h, int qb, const float* t5, float lam, const float* norm_g, float out_scale) {
    typedef short v4i16_t __attribute__((ext_vector_type(4)));
    LAS float* btab = (LAS float*)(lds + 2 * AT_BUF);
    LAS float* xch = (LAS float*)lds;
    const int tid = wave * 64 + lane, r32 = lane & 31, hi = lane >> 5, s = wave >> 2, wq = wave & 3;
    const int q0 = qb * 128, NT = 2 * qb + 2;
    const size_t row0 = (size_t)b * SEQ;
    if (tid < 128) { const int n = tid; int bk; if (n < 16) bk = n; else { bk = 16 + (int)(__logf((float)n * 0.0625f) / 2.0794415416798357f * 16.0f); bk = bk < 16 ? 16 : (bk > 31 ? 31 : bk); }
        btab[n] = (t5[bk * 4 + h] - t5[31 * 4 + h]) * LOG2E; }
    bf16x8 qr[4];
    { const bf16_t* qp = PROJ + (row0 + q0 + 32 * wq + r32) * NPROJ + PQ_C + h * 128 + 64 * s + 8 * hi;
#pragma unroll
        for (int d = 0; d < 4; ++d) qr[d] = *(const bf16x8*)(qp + 16 * d); }
    const int srow = tid >> 4, scol = (tid & 15) * 8;
    const bf16_t* kg = PROJ + (row0 + srow) * NPROJ + PK_C + h * 128 + scol; const bf16_t* vg = PROJ + (row0 + srow) * NPROJ + PV_C + h * 128 + scol;
    u32x4 sk[2], sv[2];
#define AT_LOAD(t) do { sk[0] = *(const u32x4*)(kg + (size_t)(64 * (t)) * NPROJ); sk[1] = *(const u32x4*)(kg + (size_t)(64 * (t) + 32) * NPROJ); \
                        sv[0] = *(const u32x4*)(vg + (size_t)(64 * (t)) * NPROJ); sv[1] = *(const u32x4*)(vg + (size_t)(64 * (t) + 32) * NPROJ); } while (0)
#define AT_STORE(buf) do { LAS bf16_t* kt_ = (LAS bf16_t*)(lds + (buf) * AT_BUF); LAS bf16_t* vt_ = (LAS bf16_t*)(lds + (buf) * AT_BUF + KT_BYTES); \
                        *(LAS u32x4*)(kt_ + srow * KP + scol) = sk[0]; *(LAS u32x4*)(kt_ + (srow + 32) * KP + scol) = sk[1]; \
                        *(LAS u32x4*)(vt_ + srow * VP + scol) = sv[0]; *(LAS u32x4*)(vt_ + (srow + 32) * VP + scol) = sv[1]; } while (0)
    AT_LOAD(0); AT_STORE(0);
    MIX_BAR();
    f32x16 o[4];
#pragma unroll
    for (int i = 0; i < 4; ++i)
#pragma unroll
        for (int r = 0; r < 16; ++r) o[i][r] = 0.f;
    float m_run = -1.0e30f, l_run = 0.f;
    const int qpos = q0 + 32 * wq + r32;
    constexpr float SC = 0.125f * LOG2E;
    for (int t = 0; t < NT; ++t) {
        const int buf = t & 1;
        if (t + 1 < NT) AT_LOAD(t + 1);
        const LAS bf16_t* kt_ = (const LAS bf16_t*)(lds + buf * AT_BUF); const LAS bf16_t* vt_ = (const LAS bf16_t*)(lds + buf * AT_BUF + KT_BYTES);
        f32x16 p0, p1;
#pragma unroll
        for (int r = 0; r < 16; ++r) { p0[r] = 0.f; p1[r] = 0.f; }
        { const LAS bf16_t* kp = kt_ + r32 * KP + 64 * s + 8 * hi;
#pragma unroll
            for (int d = 0; d < 4; ++d) { const bf16x8 k0 = *(const LAS bf16x8*)(kp + 16 * d), k1 = *(const LAS bf16x8*)(kp + 32 * KP + 16 * d);
                p0 = __builtin_amdgcn_mfma_f32_32x32x16_bf16(k0, qr[d], p0, 0, 0, 0); p1 = __builtin_amdgcn_mfma_f32_32x32x16_bf16(k1, qr[d], p1, 0, 0, 0); } }
        if (t >= NT - 4) {
            const int kbase = 64 * t - qpos;
#pragma unroll
            for (int r = 0; r < 16; ++r) { const int rel0 = -(kbase + crow(r, hi)), rel1 = rel0 - 32;
                p0[r] = (rel0 >= 0) ? p0[r] * SC + btab[rel0 > 127 ? 127 : rel0] : -1.0e30f;
                p1[r] = (rel1 >= 0) ? p1[r] * SC + btab[rel1 > 127 ? 127 : rel1] : -1.0e30f; }
        } else {
#pragma unroll
            for (int r = 0; r < 16; ++r) { p0[r] *= SC; p1[r] *= SC; }
        }
        float mx = fmaxf(p0[0], p1[0]);
#pragma unroll
        for (int r = 1; r < 16; ++r) mx = fmaxf(mx, fmaxf(p0[r], p1[r]));
        mx = fmaxf(mx, shx(mx, 32, lane));
        const float m_new = fmaxf(m_run, mx), alpha = fast_exp2(m_run - m_new); m_run = m_new;
        float ps = 0.f;
#pragma unroll
        for (int r = 0; r < 16; ++r) { p0[r] = fast_exp2(p0[r] - m_new); p1[r] = fast_exp2(p1[r] - m_new); ps += p0[r] + p1[r]; }
        l_run = l_run * alpha + ps;
#pragma unroll
        for (int i = 0; i < 4; ++i)
#pragma unroll
            for (int r = 0; r < 16; ++r) o[i][r] *= alpha;
        bf16x8 pf[4];
#pragma unroll
        for (int ks = 0; ks < 4; ++ks) { unsigned w[4];
#pragma unroll
            for (int j = 0; j < 4; ++j) { const int r = 8 * (ks & 1) + 2 * j; w[j] = (ks < 2) ? cvt_pk_bf16_c(p0[r], p0[r + 1]) : cvt_pk_bf16_c(p1[r], p1[r + 1]); }
            pf[ks] = __builtin_bit_cast(bf16x8, (u32x4){w[0], w[1], w[2], w[3]}); }
        const LAS bf16_t* vp = vt_ + (4 * hi + ((lane & 15) >> 2)) * VP + 16 * ((lane >> 4) & 1) + 4 * (lane & 3);
#pragma unroll
        for (int ks = 0; ks < 4; ++ks)
#pragma unroll
            for (int blk = 0; blk < 4; ++blk) {
                const s16x4 lo = __builtin_bit_cast(s16x4, __builtin_amdgcn_ds_read_tr16_b64_v4i16((LAS v4i16_t*)(vp + (16 * ks) * VP + 32 * blk)));
                const s16x4 hh = __builtin_bit_cast(s16x4, __builtin_amdgcn_ds_read_tr16_b64_v4i16((LAS v4i16_t*)(vp + (16 * ks + 8) * VP + 32 * blk)));
                const bf16x8 vf = (bf16x8){lo[0], lo[1], lo[2], lo[3], hh[0], hh[1], hh[2], hh[3]};
                o[blk] = __builtin_amdgcn_mfma_f32_32x32x16_bf16(vf, pf[ks], o[blk], 0, 0, 0);
            }
        if (t + 1 < NT) AT_STORE(buf ^ 1);
        MIX_BAR();
    }
    const float l_tot = l_run + shx(l_run, 32, lane), inv = 1.0f / l_tot;
    if (s == 1) {
#pragma unroll
        for (int i = 0; i < 4; ++i)
#pragma unroll
            for (int r = 0; r < 16; ++r) xch[(wq * 64 + i * 16 + r) * 64 + lane] = o[i][r] * inv;
    }
    MIX_LBAR();
    if (s == 0) {
        float ss = 0.f;
#pragma unroll
        for (int i = 0; i < 4; ++i)
#pragma unroll
            for (int r = 0; r < 16; ++r) { const float v = o[i][r] * inv - lam * xch[(wq * 64 + i * 16 + r) * 64 + lane]; o[i][r] = v; ss += v * v; }
        ss += shx(ss, 32, lane);
        const float rstd = out_scale / sqrtf(ss * (1.f / 128.f) + LN_EPS);
        bf16_t* op = MIXED + (row0 + qpos) * D + 1024 + h * 128;
#pragma unroll
        for (int i = 0; i < 4; ++i)
#pragma unroll
            for (int g = 0; g < 4; ++g) { const int e = 32 * i + 8 * g + 4 * hi; const f32x4 gn = *(const f32x4*)(norm_g + e);
                u32x2 w; w.x = cvt_pk_bf16_c(o[i][4 * g] * rstd * gn[0], o[i][4 * g + 1] * rstd * gn[1]); w.y = cvt_pk_bf16_c(o[i][4 * g + 2] * rstd * gn[2], o[i][4 * g + 3] * rstd * gn[3]);
                *(u32x2*)(op + e) = w; }
    }
    MIX_LBAR();
#undef AT_LOAD
#undef AT_STORE
}
}

template <int l>
__device__ __forceinline__ void mixer_phase(const Ctx& C) {
    const int lane = lane_id(); int wave = C.wave; asm volatile("" : "+s"(wave));
    const bf16_t* PROJ = (const bf16_t*)(C.ws + WS_UNION); const float* GATES = (const float*)(C.ws + WS_GATES); bf16_t* MIXED = (bf16_t*)(C.ws + WS_MIXED);
    int bx = C.bx; asm volatile("" : "+s"(bx));
    if (bx < 16) mix::gla_stream<64, false>(C.lds, wave, lane, PROJ, GATES, MIXED, bx >> 2, bx & 3, ARG_IN(I_GGW) + l * 16 * 256, ARG_IN(I_GGB) + l * 256, nullptr, nullptr, l, ARG_IN(I_GNG) + l * 128);
    else if (bx < 32) mix::gla_stream<128, true>(C.lds, wave, lane, PROJ, GATES, MIXED, (bx - 16) >> 2, bx & 3, nullptr, nullptr, ARG_IN(I_HLB), ARG_IN(I_HLB) + 512, l, ARG_IN(I_HNG) + l * 128);
    else if (bx < 48) mix::mlstm_stream(C.lds, wave, lane, PROJ, GATES, MIXED, (bx - 32) >> 2, bx & 3, ARG_IN(I_MCW) + l * 4 * 512, ARG_IN(I_MGB) + l * 8);
    const float lambda_init = (l == 0) ? 0.2f : 0.35550906759096934f;
    float lam;
    { const float* dl = ARG_IN(I_DLAM) + l * 256; const float s1 = mix::wsum(dl[lane] * dl[64 + lane], lane), s2 = mix::wsum(dl[128 + lane] * dl[192 + lane], lane); lam = __expf(s1) - __expf(s2) + lambda_init; }
    LAS unsigned* wq = (LAS unsigned*)(C.lds + LDSCTL_OFF + 64);
    unsigned* ctr = C.ctl + CW_WQ + 64 * l;
    for (;;) {
        if (wave == 0 && lane == 0) *wq = __hip_atomic_fetch_add(ctr, 1u, __ATOMIC_RELAXED, __HIP_MEMORY_SCOPE_AGENT);
        MIX_BAR();
        const unsigned u = *wq;
        MIX_LBAR();
        if (u >= 1024u) break;
        mix::diff_unit(C.lds, wave, lane, PROJ, MIXED, (int)(u & 15u) >> 2, (int)(u & 3u), 63 - (int)(u >> 4), ARG_IN(I_T5), lam, ARG_IN(I_DNG) + l * 128, 1.0f - lambda_init);
    }
}

__device__ __forceinline__ void ffn_block(const Ctx& C, const XcdBarrier& bar, const bf16_t* wfi, const bf16_t* wfo, const float* xres, const float* lng, const float* lnb) {
    bf16_t* XB = (bf16_t*)(C.ws + WS_XB); bf16_t* H = (bf16_t*)(C.ws + WS_UNION);
    {
        pg8::Gemm g{XB, wfi}; pg8::StaticOrder S; S.init(M, 2 * DFF, opq(C.G), opq(C.bx), D, D, DFF, 128);
        pg8::EpiSwiGLU E{H, DFF};
        pg8::gemm_phase<D, D, D>(C.lds, C.wave, g, S, E);
    }
    GRID_BAR();
    {
        pg8::Gemm g{H, wfo}; pg8::StaticOrder S; S.init(M, D, opq(C.G), opq(C.bx), DFF, DFF, D, 256);
        pg8::EpiRes E{xres, C.out, 0.5f};
        pg8::gemm_phase<DFF, DFF, DFF>(C.lds, C.wave, g, S, E);
    }
    GRID_BAR();
    ln_phase(C.out, XB, lng, lnb, C.gw, C.NGW);
    GRID_BAR();
}

template <int l> __device__ __forceinline__ void layer_body(const Ctx& C, const XcdBarrier& bar) {
    unsigned char* ws = C.ws; bf16_t* XB = (bf16_t*)(ws + WS_XB);
        const float* lng = ARG_IN(I_LNG) + (size_t)l * 4 * D; const float* lnb = ARG_IN(I_LNB) + (size_t)l * 4 * D;
        ffn_block(C, bar, (const bf16_t*)(ws + WS_WFI + (size_t)(l * 2 + 0) * SZ_WFI), (const bf16_t*)(ws + WS_WFO + (size_t)(l * 2 + 0) * SZ_WFO),
                  l == 0 ? ARG_IN(I_X) : (const float*)ARG_OUT(), lng, lnb);
        {
            pg8::Gemm g{XB, (const bf16_t*)(ws + WS_WMI + l * SZ_WMI)}; pg8::StaticOrder S; S.init(M, NPROJ, opq(C.G), opq(C.bx), D, D, NPROJ, 256);
            pg8::EpiBf16 E{(bf16_t*)(ws + WS_UNION), NPROJ, 1.0f, (float*)(ws + WS_GATES), 26};
            pg8::gemm_phase<D, D, D>(C.lds, C.wave, g, S, E);
        }
        GRID_BAR();
        mixer_phase<l>(C);
        GRID_BAR();
        {
            pg8::Gemm g{(const bf16_t*)(ws + WS_MIXED), (const bf16_t*)(ws + WS_WMO + l * SZ_WDD)}; pg8::StaticOrder S; S.init(M, D, opq(C.G), opq(C.bx), D, D, D, 256);
            pg8::EpiRes E{ARG_OUT(), ARG_OUT(), 1.0f};
            pg8::gemm_phase<D, D, D>(C.lds, C.wave, g, S, E);
        }
        GRID_BAR();
        ln_phase(ARG_OUT(), XB, lng + D, lnb + D, C.gw, C.NGW);
        GRID_BAR();
        {
            pg8::Gemm g{XB, (const bf16_t*)(ws + WS_WXQ + l * SZ_WDD)}; pg8::StaticOrder S; S.init(M, D, opq(C.G), opq(C.bx), D, D, D, 256);
            pg8::EpiBf16 E{(bf16_t*)(ws + WS_UNION + UN_Q), D, 0.04419417382415922f * LOG2E, nullptr, -1};
            pg8::gemm_phase<D, D, D>(C.lds, C.wave, g, S, E);
        }
        GRID_BAR();
        {
            pg8::Gemm g{(const bf16_t*)(ws + WS_UNION + UN_Q), (const bf16_t*)(ws + WS_KB + (size_t)l * BATCH * NMEM * D * 2)}; XsOrder S{opq(C.G), opq(C.bx)};
            pg8::EpiSoftmax E{(bf16_t*)(ws + WS_UNION + UN_P), 1024};
            pg8::gemm_phase<D, D, 512>(C.lds, C.wave, g, S, E);
        }
        GRID_BAR();
        {
            pg8::Gemm g{(const bf16_t*)(ws + WS_UNION + UN_P), (const bf16_t*)(ws + WS_VT + (size_t)l * BATCH * NMEM * D * 2)}; XpvOrder S{opq(C.G), opq(C.bx)};
            pg8::EpiBf16 E{(bf16_t*)(ws + WS_UNION + UN_O), D, 1.0f, nullptr, -1};
            pg8::gemm_phase<1024, 1024, 256>(C.lds, C.wave, g, S, E);
        }
        GRID_BAR();
        {
            pg8::Gemm g{(const bf16_t*)(ws + WS_UNION + UN_O), (const bf16_t*)(ws + WS_WXO + l * SZ_WDD)}; pg8::StaticOrder S; S.init(M, D, opq(C.G), opq(C.bx), D, D, D, 256);
            pg8::EpiRes E{ARG_OUT(), ARG_OUT(), 1.0f};
            pg8::gemm_phase<D, D, D>(C.lds, C.wave, g, S, E);
        }
        GRID_BAR();
        ln_phase(ARG_OUT(), XB, lng + 2 * D, lnb + 2 * D, C.gw, C.NGW);
        GRID_BAR();
        ffn_block(C, bar, (const bf16_t*)(ws + WS_WFI + (size_t)(l * 2 + 1) * SZ_WFI), (const bf16_t*)(ws + WS_WFO + (size_t)(l * 2 + 1) * SZ_WFO),
                  (const float*)ARG_OUT(), lng + 3 * D, lnb + 3 * D);
}

__global__ void __launch_bounds__(NWAVES * 64, 2) hybrid_fwd(Args args) {
    extern __shared__ __attribute__((aligned(16))) unsigned char lds_raw[];
    Ctx C;
    C.lds = (LAS unsigned char*)lds_raw;
    C.wave = __builtin_amdgcn_readfirstlane(threadIdx.x >> 6);
    C.G = gridDim.x; C.bx = blockIdx.x; C.gw = C.bx * NWAVES + C.wave; C.NGW = C.G * NWAVES;
    C.ws = args.ws; C.out = ARG_OUT(); C.ctl = (unsigned*)(args.ws + WS_CTL);
    volatile LAS unsigned* MISC = (volatile LAS unsigned*)(C.lds + MISC_OFF);
    for (int u = threadIdx.x; u < 128; u += NWAVES * 64) ((LAS unsigned*)(C.lds + LDSCTL_OFF))[u] = 0u;
    __syncthreads();
    XcdBarrier bar = xcd_barrier_post(C.ctl + CW_BAR, MISC + 8);
    unsigned char* ws = args.ws;
    bf16_t* XB = (bf16_t*)(ws + WS_XB); bf16_t* MEMB = (bf16_t*)(ws + WS_MEMB);

    {
        LAS float* scr = (LAS float*)(C.lds + C.wave * 16384);
        for (int lj = 0; lj < 4; ++lj) {
            transpose_matrix(ARG_IN(I_FWI) + (size_t)lj * D * 2 * DFF, D, 2 * DFF, 2 * DFF, (bf16_t*)(ws + WS_WFI + lj * SZ_WFI), scr, C.gw, C.NGW, MapFfnIn());
            transpose_matrix(ARG_IN(I_FWO) + (size_t)lj * DFF * D, DFF, D, D, (bf16_t*)(ws + WS_WFO + lj * SZ_WFO), scr, C.gw, C.NGW, MapId());
        }
        for (int l = 0; l < DEPTH; ++l) {
            transpose_matrix(ARG_IN(I_WIN) + (size_t)l * D * NIN, D, NIN, NPROJ, (bf16_t*)(ws + WS_WMI + l * SZ_WMI), scr, C.gw, C.NGW, MapMixIn());
            transpose_matrix(ARG_IN(I_WOUT) + (size_t)l * D * D, D, D, D, (bf16_t*)(ws + WS_WMO + l * SZ_WDD), scr, C.gw, C.NGW, MapId());
            transpose_matrix(ARG_IN(I_XWQ) + (size_t)l * D * D, D, D, D, (bf16_t*)(ws + WS_WXQ + l * SZ_WDD), scr, C.gw, C.NGW, MapId());
            transpose_matrix(ARG_IN(I_XWKV) + (size_t)l * D * 2 * D, D, 2 * D, 2 * D, (bf16_t*)(ws + WS_WXKV + l * SZ_WKV), scr, C.gw, C.NGW, MapId());
            transpose_matrix(ARG_IN(I_XWO) + (size_t)l * D * D, D, D, D, (bf16_t*)(ws + WS_WXO + l * SZ_WDD), scr, C.gw, C.NGW, MapId());
        }
        const size_t gt = (size_t)C.bx * (NWAVES * 64) + C.wave * 64 + lane_id(), NGT = (size_t)C.G * (NWAVES * 64);
        cvt_copy(ARG_IN(I_X), XB, (size_t)M * D, gt, NGT);
        cvt_copy(ARG_IN(I_MEM), MEMB, (size_t)BATCH * NMEM * D, gt, NGT);
    }
    GRID_BAR();
    for (int l = 0; l < DEPTH; ++l) {
        const bf16_t* wkv = (const bf16_t*)(ws + WS_WXKV + l * SZ_WKV);
        {
            pg8::Gemm g{MEMB, wkv}; pg8::StaticOrder S; S.init(BATCH * NMEM, D, opq(C.G), opq((C.bx + C.G - 64 * l) % C.G), D, D, D, 256);
            pg8::EpiBf16 E{(bf16_t*)(ws + WS_KB + (size_t)l * BATCH * NMEM * D * 2), D, 1.0f, nullptr, -1};
            pg8::gemm_phase<D, D, D>(C.lds, C.wave, g, S, E);
        }
        {
            pg8::Gemm g{wkv + (size_t)D * D, MEMB}; pg8::StaticOrder S; S.init(D, BATCH * NMEM, opq(C.G), opq((C.bx + C.G - 64 * l - 32) % C.G), D, D, BATCH * NMEM, 256);
            pg8::EpiBf16 E{(bf16_t*)(ws + WS_VT + (size_t)l * BATCH * NMEM * D * 2), BATCH * NMEM, 1.0f, nullptr, -1};
            pg8::gemm_phase<D, D, D>(C.lds, C.wave, g, S, E);
        }
    }
    GRID_BAR();

    layer_body<0>(C, bar);
    layer_body<1>(C, bar);
}

extern "C" void kernel_launch(void* const* d_in, const int* in_sizes, int n_in, void* d_out, int out_size, void* d_ws, size_t ws_size, hipStream_t stream) {
    static int grid = 0;
    if (grid == 0) {
        if (n_in != 21 || out_size != M * D || ws_size < WS_END) { fprintf(stderr, "kernel_launch: unexpected problem (n_in %d out %d ws %zu, need %zu)\n", n_in, out_size, ws_size, (size_t)WS_END); grid = -1; return; }
        int dev = 0, cus = 0, per_cu = 0;
        if (hipGetDevice(&dev) != hipSuccess || hipDeviceGetAttribute(&cus, hipDeviceAttributeMultiprocessorCount, dev) != hipSuccess) { grid = -1; return; }
        if (hipFuncSetAttribute((const void*)hybrid_fwd, hipFuncAttributeMaxDynamicSharedMemorySize, LDS_BYTES) != hipSuccess) { fprintf(stderr, "kernel_launch: hipFuncSetAttribute failed\n"); grid = -1; return; }
        if (hipOccupancyMaxActiveBlocksPerMultiprocessor(&per_cu, (const void*)hybrid_fwd, NWAVES * 64, LDS_BYTES) != hipSuccess || per_cu < 1) { fprintf(stderr, "kernel_launch: occupancy query says %d\n", per_cu); (void)hipGetLastError(); grid = -1; return; }
        grid = cus;
    }
    if (grid < 0) return;
    if (hipMemsetAsync((char*)d_ws + WS_CTL, 0, CTL_ZERO_BYTES, stream) != hipSuccess) return;
    Args a{};
    for (int i = 0; i < 21; ++i) a.in[i] = (const float*)d_in[i];
    a.out = (float*)d_out; a.ws = (unsigned char*)d_ws;
    hipLaunchKernelGGL(hybrid_fwd, dim3(grid), dim3(NWAVES * 64), LDS_BYTES, stream, a);
}
```

```cpp
#include <hip/hip_runtime.h>
#include <hip/hip_bf16.h>
#include <cstdio>
#include <cstdint>
#include <cmath>

#define LAS __attribute__((address_space(3)))
#define GAS __attribute__((address_space(1)))
typedef unsigned short bf16_t;
typedef short bf16x8 __attribute__((ext_vector_type(8)));
typedef short s16x4 __attribute__((ext_vector_type(4)));
typedef float f32x4 __attribute__((ext_vector_type(4)));
typedef float f32x2 __attribute__((ext_vector_type(2)));
typedef float f32x16 __attribute__((ext_vector_type(16)));
typedef unsigned u32x4 __attribute__((ext_vector_type(4)));
typedef unsigned u32x2 __attribute__((ext_vector_type(2)));

constexpr int D = 2048, BATCH = 4, SEQ = 8192, M = BATCH * SEQ, DEPTH = 2, NMEM = 256, DFF = 5632;
constexpr int NIN = 6680, NPROJ = 6912;
constexpr float LN_EPS = 1e-5f;
constexpr float ALPHA = 1.41421356237309515f;
constexpr float LOG2E = 1.4426950408889634f;
constexpr int PQ_A = 0, PK_A = 256, PV_A = 512, PR_A = 1024, PQ_B = 1536, PF_B = 2048, PI_B = 2560, PG_B = 3072,
              PQ_C = 3584, PK_C = 4096, PV_C = 4608, PQ_D = 5120, PK_D = 5376, PV_D = 5632, PO_D = 6144, P_SMALL = 6656;

__device__ __forceinline__ int lane_id() { int l; asm volatile("v_mbcnt_lo_u32_b32 %0, -1, 0\n\tv_mbcnt_hi_u32_b32 %0, -1, %0" : "=v"(l)); return l; }
__device__ __forceinline__ float shx(float v, int m, int lane) { return __int_as_float(__builtin_amdgcn_ds_bpermute((lane ^ m) << 2, __float_as_int(v))); }
typedef __bf16 bf16x2_t __attribute__((ext_vector_type(2)));
__device__ __forceinline__ unsigned cvt_pk_bf16(float lo, float hi) { unsigned r; asm volatile("v_cvt_pk_bf16_f32 %0, %1, %2" : "=v"(r) : "v"(lo), "v"(hi)); return r; }
__device__ __forceinline__ unsigned cvt_pk_bf16_c(float lo, float hi) { f32x2 v = {lo, hi}; bf16x2_t b = __builtin_convertvector(v, bf16x2_t); return __builtin_bit_cast(unsigned, b); }
__device__ __forceinline__ float bf2f(unsigned short b) { return __uint_as_float(((unsigned)b) << 16); }
__device__ __forceinline__ float bflo(unsigned w) { return __uint_as_float(w << 16); }
__device__ __forceinline__ float bfhi(unsigned w) { return __uint_as_float(w & 0xffff0000u); }
__device__ __forceinline__ unsigned short f2bf(float f) { return (unsigned short)(cvt_pk_bf16_c(f, 0.f) & 0xffffu); }
__device__ __forceinline__ float fast_exp2(float x) { return __builtin_amdgcn_exp2f(x); }
__device__ __forceinline__ float fast_exp(float x) { return __builtin_amdgcn_exp2f(x * LOG2E); }
__device__ __forceinline__ float fast_rcp(float x) { return __builtin_amdgcn_rcpf(x); }
__device__ __forceinline__ float sigmoidf_(float x) { return fast_rcp(1.f + fast_exp(-x)); }
__device__ __forceinline__ float siluf_(float x) { return x * sigmoidf_(x); }
__device__ __forceinline__ float logsigmoidf_(float x) { return fminf(x, 0.f) - log1pf(__expf(-fabsf(x))); }

namespace pg8 {
constexpr int BM = 256, BK = 64, HALF = 128, HTB = HALF * BK * 2, STAGE_BYTES = 8 * HTB, NXCD = 8, WGM = 8;
__host__ __device__ __forceinline__ int lds_byte(int r, int c) { const int st = (r >> 4) * 2 + (c >> 5), rr = r & 15, cc = c & 31, ob = rr * 64 + cc * 2; return st * 1024 + (ob ^ (((ob >> 9) & 1) << 5)); }
__host__ __device__ __forceinline__ void stage_rc(int b, int& R, int& C) { const int st = b / 1024, sb = b % 1024, swz = sb ^ (((sb >> 9) & 1) << 5); R = (st >> 1) * 16 + swz / 64; C = (st & 1) * 32 + (swz % 64) / 2; }
__host__ __device__ __forceinline__ int perm32(int rho) { const int n = rho >> 4, i = rho & 15; return 8 * (i >> 2) + 4 * n + (i & 3); }

struct Unit { int pm, pn; unsigned aoff, boff, coff; };
struct Gemm { const bf16_t* A; const bf16_t* Bt; };

struct StaticOrder {
    int nM, nN, nwg, G, c, lda, ldb, ldc, cw;
    __device__ void init(int Mr, int Nc, int G_, int c_, int lda_, int ldb_, int ldc_, int cw_) { nM = Mr / BM; nN = Nc / BM; nwg = nM * nN; G = G_; c = c_; lda = lda_; ldb = ldb_; ldc = ldc_; cw = cw_; }
    __device__ bool next(int i, Unit& u) const {
        const long L = (long)i * G + c; if (L >= nwg || c < 0) return false;
        int wgid = (int)L; { const int q = nwg / NXCD, r = nwg % NXCD, xcd = wgid % NXCD, off = wgid / NXCD; wgid = (xcd < r ? xcd * (q + 1) : r * (q + 1) + (xcd - r) * q) + off; }
        const int nig = WGM * nN, gid = wgid / nig, fm = gid * WGM, gsz = (nM - fm) < WGM ? (nM - fm) : WGM;
        u.pm = fm + ((wgid % nig) % gsz); u.pn = (wgid % nig) / gsz;
        u.aoff = (unsigned)(u.pm * BM) * (unsigned)lda; u.boff = (unsigned)(u.pn * BM) * (unsigned)ldb; u.coff = (unsigned)(u.pm * BM) * (unsigned)ldc + (unsigned)(u.pn * cw); return true;
    }
};

template <int LDA, int LDB, int KK, class Epi, class Sched>
__device__ __forceinline__ void gemm_phase(LAS unsigned char* lds, int wave, const Gemm g, const Sched& S, const Epi& E) {
    int tid_ = wave * 64 + lane_id();
    int wid_ = wave; asm volatile("" : "+s"(wid_));
    const int tid = tid_, wid = wid_, lane = tid & 63, wr = wid >> 2, wc = wid & 3, fr = lane & 15, fq = lane >> 4;
    constexpr int nt = KK / BK;
    unsigned voffA[2], voffB[2];
#pragma unroll
    for (int i = 0; i < 2; ++i) { int R, C; stage_rc(tid * 16 + i * 8192, R, C); const int Rb = Epi::PERM ? ((R & ~31) + perm32(R & 31)) : R;
        voffA[i] = (unsigned)(R * LDA + C) * 2u; voffB[i] = (unsigned)(Rb * LDB + C) * 2u; }
    constexpr size_t kstep = (size_t)(BK * 2);
    constexpr size_t hstepA = (size_t)HALF * LDA * 2, hstepB = (size_t)HALF * LDB * 2;
    const unsigned ldsw = (unsigned)wid * 1024u;
    const int aoff = lds_byte(wr * 64 + fr, fq * 8), boff = lds_byte(wc * 32 + fr, fq * 8);
#define PG8_SA(b, h) (((b) * 2 + (h)) * HTB)
#define PG8_SB(b, h) ((4 + (b) * 2 + (h)) * HTB)
#define PG8_STAGE(bufoff, gbase, voff) do { _Pragma("unroll") for (int _i = 0; _i < 2; ++_i) \
        __builtin_amdgcn_global_load_lds((const unsigned*)((const char*)(gbase) + (voff)[_i]), (LAS unsigned*)(lds + (bufoff) + ldsw + _i * 8192), 16, 0, 0); } while (0)
#define PG8_LDA(dst, b, h) do { _Pragma("unroll") for (int m = 0; m < 4; ++m) _Pragma("unroll") for (int k = 0; k < 2; ++k) dst[m][k] = *(const LAS bf16x8*)(lds + PG8_SA(b, h) + aoff + m * 2048 + k * 1024); } while (0)
#define PG8_LDB(dst, b, h) do { _Pragma("unroll") for (int n = 0; n < 2; ++n) _Pragma("unroll") for (int k = 0; k < 2; ++k) dst[n][k] = *(const LAS bf16x8*)(lds + PG8_SB(b, h) + boff + n * 2048 + k * 1024); } while (0)
#define PG8_MMA(ai, bj, At, Bt) do { __builtin_amdgcn_s_setprio(1); _Pragma("unroll") for (int m = 0; m < 4; ++m) _Pragma("unroll") for (int n = 0; n < 2; ++n) _Pragma("unroll") for (int k = 0; k < 2; ++k) \
        acc[ai][bj][m][n] = __builtin_amdgcn_mfma_f32_16x16x32_bf16(Bt[n][k], At[m][k], acc[ai][bj][m][n], 0, 0, 0); __builtin_amdgcn_s_setprio(0); } while (0)
#define PG8_WAIT_V(n) asm volatile("s_waitcnt vmcnt(" #n ")" ::: "memory")
#define PG8_WAIT_L(n) asm volatile("s_waitcnt lgkmcnt(" #n ")" ::: "memory")
#define PG8_BAR __builtin_amdgcn_s_barrier()
#define PG8_SCHED __builtin_amdgcn_sched_barrier(0)
    Unit cur, nxt; int ui = 0;
    if (!S.next(0, cur)) return;
    f32x4 acc[2][2][4][2];
#pragma unroll
    for (int a = 0; a < 2; ++a)
#pragma unroll
        for (int b = 0; b < 2; ++b)
#pragma unroll
            for (int m = 0; m < 4; ++m)
#pragma unroll
                for (int n = 0; n < 2; ++n) acc[a][b][m][n] = (f32x4){0.f, 0.f, 0.f, 0.f};
    bf16x8 At[4][2], B0[2][2], B1[2][2];
    const char* cA = (const char*)(g.A + cur.aoff); const char* cB = (const char*)(g.Bt + cur.boff);
    PG8_STAGE(PG8_SB(0, 0), cB, voffB); PG8_STAGE(PG8_SB(0, 1), cB + hstepB, voffB); PG8_STAGE(PG8_SA(0, 0), cA, voffA); PG8_STAGE(PG8_SA(0, 1), cA + hstepA, voffA);
    if (wr == 1) PG8_BAR;
    PG8_WAIT_V(2); PG8_BAR;
    PG8_STAGE(PG8_SB(1, 0), cB + kstep, voffB); PG8_STAGE(PG8_SA(1, 0), cA + kstep, voffA); PG8_STAGE(PG8_SB(1, 1), cB + hstepB + kstep, voffB);
    PG8_WAIT_V(6); PG8_BAR;
    for (;;) {
        const bool has_next = S.next(ui + 1, nxt);
        const char* nA = has_next ? (const char*)(g.A + nxt.aoff) : cA; const char* nB = has_next ? (const char*)(g.Bt + nxt.boff) : cB;
        for (int t = 0; t < nt; t += 2) {
            const bool last = (t == nt - 2);
            const char* a1 = cA + (size_t)(t + 1) * kstep;
            const char* a2 = last ? nA : cA + (size_t)(t + 2) * kstep; const char* b2 = last ? nB : cB + (size_t)(t + 2) * kstep;
            const char* a3 = a2 + kstep; const char* b3 = b2 + kstep;
            PG8_LDB(B0, 0, 0); PG8_LDB(B1, 0, 1); PG8_SCHED; PG8_LDA(At, 0, 0); PG8_STAGE(PG8_SA(1, 1), a1 + hstepA, voffA);
            PG8_WAIT_V(8); PG8_WAIT_L(0); PG8_BAR; PG8_MMA(0, 0, At, B0); PG8_MMA(0, 1, At, B1); PG8_BAR; PG8_SCHED;
            PG8_LDA(At, 0, 1); PG8_STAGE(PG8_SB(0, 0), b2, voffB); PG8_STAGE(PG8_SB(0, 1), b2 + hstepB, voffB); PG8_STAGE(PG8_SA(0, 0), a2, voffA);
            PG8_WAIT_V(8); PG8_WAIT_L(0); PG8_BAR; PG8_MMA(1, 0, At, B0); PG8_MMA(1, 1, At, B1); PG8_BAR; PG8_SCHED;
            PG8_LDB(B0, 1, 0); PG8_LDB(B1, 1, 1); PG8_SCHED; PG8_LDA(At, 1, 0); PG8_STAGE(PG8_SA(0, 1), a2 + hstepA, voffA);
            PG8_WAIT_V(8); PG8_WAIT_L(0); PG8_BAR; PG8_MMA(0, 0, At, B0); PG8_MMA(0, 1, At, B1); PG8_BAR; PG8_SCHED;
            PG8_LDA(At, 1, 1); PG8_STAGE(PG8_SB(1, 0), b3, voffB); PG8_STAGE(PG8_SB(1, 1), b3 + hstepB, voffB); PG8_STAGE(PG8_SA(1, 0), a3, voffA);
            PG8_WAIT_V(8); PG8_WAIT_L(0); PG8_BAR; PG8_MMA(1, 0, At, B0); PG8_MMA(1, 1, At, B1); PG8_BAR; PG8_SCHED;
        }
        if (wr == 0) PG8_BAR;
        { int fr_e = fr, fq_e = fq, wr_e = wr, wc_e = wc; asm volatile("" : "+v"(fr_e), "+v"(fq_e), "+s"(wr_e), "+s"(wc_e));
          E(acc, cur, wr_e, wc_e, fr_e, fq_e, lds); }
        if (!has_next) break;
#pragma unroll
        for (int a = 0; a < 2; ++a)
#pragma unroll
            for (int b = 0; b < 2; ++b)
#pragma unroll
                for (int m = 0; m < 4; ++m)
#pragma unroll
                    for (int n = 0; n < 2; ++n) acc[a][b][m][n] = (f32x4){0.f, 0.f, 0.f, 0.f};
        cur = nxt; cA = nA; cB = nB; ++ui;
        if (wr == 1) PG8_BAR;
    }
    PG8_WAIT_V(0);
    PG8_BAR;
#undef PG8_SA
#undef PG8_SB
#undef PG8_STAGE
#undef PG8_LDA
#undef PG8_LDB
#undef PG8_MMA
#undef PG8_WAIT_V
#undef PG8_WAIT_L
#undef PG8_SCHED
}

constexpr int EPI_LDS_OFF = 135168;

struct EpiSwiGLU {
    static constexpr bool PERM = true;
    bf16_t* H; int ldh;
    __device__ __forceinline__ void operator()(const f32x4 (&acc)[2][2][4][2], const Unit& u, int wr, int wc, int fr, int fq, LAS unsigned char*) const {
        bf16_t* base = H + u.coff + (size_t)(wr * 64 + fr) * ldh + wc * 32 + 8 * fq;
#pragma unroll
        for (int ai = 0; ai < 2; ++ai)
#pragma unroll
            for (int m = 0; m < 4; ++m) {
                const f32x4 g0 = acc[ai][0][m][0], g1 = acc[ai][0][m][1], u0 = acc[ai][1][m][0], u1 = acc[ai][1][m][1];
                float h[8];
#pragma unroll
                for (int i = 0; i < 4; ++i) { h[i] = siluf_(g0[i]) * u0[i]; h[4 + i] = siluf_(g1[i]) * u1[i]; }
                u32x4 w; w.x = cvt_pk_bf16(h[0], h[1]); w.y = cvt_pk_bf16(h[2], h[3]); w.z = cvt_pk_bf16(h[4], h[5]); w.w = cvt_pk_bf16(h[6], h[7]);
                *(u32x4*)(base + (size_t)(ai * HALF + m * 16) * ldh) = w;
            }
    }
};
struct EpiRes {
    static constexpr bool PERM = false;
    const float* X; float* Y; float s;
    __device__ __forceinline__ void operator()(const f32x4 (&acc)[2][2][4][2], const Unit& u, int wr, int wc, int fr, int fq, LAS unsigned char*) const {
        const size_t o0 = u.coff + (size_t)(wr * 64 + fr) * D + wc * 32 + 4 * fq;
#pragma unroll
        for (int ai = 0; ai < 2; ++ai)
#pragma unroll
            for (int m = 0; m < 4; ++m) { const size_t off = o0 + (size_t)(ai * HALF + m * 16) * D;
#pragma unroll
                for (int bj = 0; bj < 2; ++bj)
#pragma unroll
                    for (int n = 0; n < 2; ++n) { const f32x4 x = *(const f32x4*)(X + off + bj * HALF + n * 16); *(f32x4*)(Y + off + bj * HALF + n * 16) = x * ALPHA + acc[ai][bj][m][n] * s; } }
    }
};
struct EpiBf16 {
    static constexpr bool PERM = true;
    bf16_t* O; int ldc; float scale; float* G; int gate_tile;
    __device__ __forceinline__ void operator()(const f32x4 (&acc)[2][2][4][2], const Unit& u, int wr, int wc, int fr, int fq, LAS unsigned char*) const {
        bf16_t* base = O + u.coff + (size_t)(wr * 64 + fr) * ldc + wc * 32 + 8 * fq;
#pragma unroll
        for (int ai = 0; ai < 2; ++ai)
#pragma unroll
            for (int m = 0; m < 4; ++m) { bf16_t* rowp = base + (size_t)(ai * HALF + m * 16) * ldc;
#pragma unroll
                for (int bj = 0; bj < 2; ++bj) { const f32x4 v0 = acc[ai][bj][m][0] * scale, v1 = acc[ai][bj][m][1] * scale;
                    u32x4 w; w.x = cvt_pk_bf16(v0[0], v0[1]); w.y = cvt_pk_bf16(v0[2], v0[3]); w.z = cvt_pk_bf16(v1[0], v1[1]); w.w = cvt_pk_bf16(v1[2], v1[3]);
                    *(u32x4*)(rowp + bj * HALF) = w; } }
        if (G != nullptr && u.pn == gate_tile && wc == 0) {
#pragma unroll
            for (int ai = 0; ai < 2; ++ai)
#pragma unroll
                for (int m = 0; m < 4; ++m) { float* gp = G + (size_t)(u.pm * BM + ai * HALF + wr * 64 + m * 16 + fr) * 32 + 8 * fq;
                    *(f32x4*)(gp) = acc[ai][0][m][0]; *(f32x4*)(gp + 4) = acc[ai][0][m][1]; }
        }
    }
};
struct EpiSoftmax {
    static constexpr bool PERM = true;
    bf16_t* P; int ldc;
    __device__ __forceinline__ void operator()(f32x4 (&acc)[2][2][4][2], const Unit& u, int wr, int wc, int fr, int fq, LAS unsigned char* lds) const {
        LAS float* smax = (LAS float*)(lds + EPI_LDS_OFF); LAS float* ssum = smax + 1024;
#pragma unroll
        for (int ai = 0; ai < 2; ++ai)
#pragma unroll
            for (int m = 0; m < 4; ++m) { float mx = -3.0e38f;
#pragma unroll
                for (int bj = 0; bj < 2; ++bj)
#pragma unroll
                    for (int n = 0; n < 2; ++n) { const f32x4 x = acc[ai][bj][m][n]; mx = fmaxf(mx, fmaxf(fmaxf(x[0], x[1]), fmaxf(x[2], x[3]))); }
                mx = fmaxf(mx, shx(mx, 16, fr + 16 * fq)); mx = fmaxf(mx, shx(mx, 32, fr + 16 * fq));
                if (fq == 0) smax[wc * 256 + ai * HALF + wr * 64 + m * 16 + fr] = mx; }
        asm volatile("s_waitcnt lgkmcnt(0)" ::: "memory"); PG8_BAR; asm volatile("" ::: "memory");
#pragma unroll
        for (int ai = 0; ai < 2; ++ai)
#pragma unroll
            for (int m = 0; m < 4; ++m) { const int r = ai * HALF + wr * 64 + m * 16 + fr;
                const float mx = fmaxf(fmaxf(smax[r], smax[256 + r]), fmaxf(smax[512 + r], smax[768 + r])); float s = 0.f;
#pragma unroll
                for (int bj = 0; bj < 2; ++bj)
#pragma unroll
                    for (int n = 0; n < 2; ++n) { f32x4 x = acc[ai][bj][m][n];
                        x[0] = fast_exp2(x[0] - mx); x[1] = fast_exp2(x[1] - mx); x[2] = fast_exp2(x[2] - mx); x[3] = fast_exp2(x[3] - mx);
                        s += (x[0] + x[1]) + (x[2] + x[3]); acc[ai][bj][m][n] = x; }
                s += shx(s, 16, fr + 16 * fq); s += shx(s, 32, fr + 16 * fq);
                if (fq == 0) ssum[wc * 256 + r] = s; }
        asm volatile("s_waitcnt lgkmcnt(0)" ::: "memory"); PG8_BAR; asm volatile("" ::: "memory");
        bf16_t* base = P + u.coff + (size_t)(wr * 64 + fr) * ldc + wc * 32 + 8 * fq;
#pragma unroll
        for (int ai = 0; ai < 2; ++ai)
#pragma unroll
            for (int m = 0; m < 4; ++m) { const int r = ai * HALF + wr * 64 + m * 16 + fr;
                const float inv = 1.0f / ((ssum[r] + ssum[256 + r]) + (ssum[512 + r] + ssum[768 + r]));
                bf16_t* rowp = base + (size_t)(ai * HALF + m * 16) * ldc;
#pragma unroll
                for (int bj = 0; bj < 2; ++bj) { const f32x4 v0 = acc[ai][bj][m][0] * inv, v1 = acc[ai][bj][m][1] * inv;
                    u32x4 w; w.x = cvt_pk_bf16(v0[0], v0[1]); w.y = cvt_pk_bf16(v0[2], v0[3]); w.z = cvt_pk_bf16(v1[0], v1[1]); w.w = cvt_pk_bf16(v1[2], v1[3]);
                    *(u32x4*)(rowp + bj * HALF) = w; } }
    }
};
#undef PG8_BAR
}

constexpr size_t MiB = 1u << 20;
constexpr size_t SZ_WFI = (size_t)2 * DFF * D * 2, SZ_WFO = (size_t)D * DFF * 2, SZ_WMI = (size_t)NPROJ * D * 2, SZ_WDD = (size_t)D * D * 2, SZ_WKV = (size_t)2 * D * D * 2;
constexpr size_t WS_CTL = 0, CTL_ZERO_BYTES = 1 * MiB;
constexpr size_t WS_WFI = 2 * MiB;
constexpr size_t WS_WFO = WS_WFI + 4 * SZ_WFI;
constexpr size_t WS_WMI = WS_WFO + 4 * SZ_WFO;
constexpr size_t WS_WMO = WS_WMI + 2 * SZ_WMI;
constexpr size_t WS_WXQ = WS_WMO + 2 * SZ_WDD;
constexpr size_t WS_WXKV = WS_WXQ + 2 * SZ_WDD;
constexpr size_t WS_WXO = WS_WXKV + 2 * SZ_WKV;
constexpr size_t WS_XB = WS_WXO + 2 * SZ_WDD;
constexpr size_t WS_MEMB = WS_XB + (size_t)M * D * 2;
constexpr size_t WS_KB = WS_MEMB + (size_t)BATCH * NMEM * D * 2;
constexpr size_t WS_VT = WS_KB + (size_t)DEPTH * BATCH * NMEM * D * 2;
constexpr size_t WS_GATES = WS_VT + (size_t)DEPTH * BATCH * NMEM * D * 2;
constexpr size_t WS_MIXED = WS_GATES + (size_t)M * 32 * 4;
constexpr size_t WS_UNION = WS_MIXED + (size_t)M * D * 2;
constexpr size_t WS_END = WS_UNION + (size_t)M * NPROJ * 2;
constexpr size_t UN_Q = 0, UN_P = (size_t)M * D * 2, UN_O = UN_P + (size_t)M * 1024 * 2;
static_assert(WS_END < (size_t)1400 * MiB, "workspace map");
constexpr int CW_TMO = 0, CW_BAR = 4096, CW_WQ = 16384;

constexpr int LDS_BYTES = 163840;
constexpr int RING_BYTES = 131072, LDSCTL_OFF = LDS_BYTES - 512, MISC_OFF = LDSCTL_OFF + 320;
constexpr int NWAVES = 8;

#define RLX_AGENT __ATOMIC_RELAXED, __HIP_MEMORY_SCOPE_AGENT
#define LDS_WAIT() asm volatile("s_waitcnt lgkmcnt(0)" ::: "memory")
#define VM_WAIT() asm volatile("s_waitcnt vmcnt(0)" ::: "memory")

#define XB_TMO      128
#define XB_XCNT(j)  (256  + 64 * (j))
#define XB_XSUB(j)  (1280 + 64 * (j))
#define XB_XGEN(j)  (2304 + 64 * (j))
#define XB_TOP      3328
#define XB_TOPGEN   3392
#define XCD_BAR_WORDS 3456
#define XB_SPIN_CAP (1u << 20)
__device__ __forceinline__ unsigned xb_ld(unsigned* p)              { return __hip_atomic_load(p, __ATOMIC_RELAXED, __HIP_MEMORY_SCOPE_AGENT); }
__device__ __forceinline__ unsigned xb_add(unsigned* p, unsigned v) { return __hip_atomic_fetch_add(p, v, __ATOMIC_RELAXED, __HIP_MEMORY_SCOPE_AGENT); }
__device__ __forceinline__ unsigned xb_xcc_id() { return (unsigned)__builtin_amdgcn_s_getreg((3 << 11) | 20) & 0xFu; }
#define XB_SPIN(cond, bar) do { unsigned _sp = 0; while (cond) { __builtin_amdgcn_s_sleep(1); \
    if ((++_sp & 255u) == 0u) { if (xb_ld(&(bar)[XB_TMO])) break; if (_sp > XB_SPIN_CAP) { atomicAdd(&(bar)[XB_TMO], 1u); break; } } } } while (0)
struct XcdBarrier { unsigned* bar; unsigned x; volatile LAS unsigned* st; };
__device__ __forceinline__ XcdBarrier xcd_barrier_post(unsigned* bar, volatile LAS unsigned* st) {
    XcdBarrier b; b.bar = bar; b.x = xb_xcc_id(); b.st = st;
    if (threadIdx.x == 0) (void)xb_add(&bar[XB_XCNT(b.x)], 1u);
    return b;
}
__device__ __forceinline__ void xcd_barrier_complete(unsigned* bar, unsigned x, unsigned& nloc, unsigned& nx) {
    const unsigned G = gridDim.x * gridDim.y * gridDim.z;
    unsigned sum, cnt, mine, sp = 0u;
    for (;;) {
        sum = 0u; cnt = 0u; mine = 0u;
#pragma unroll
        for (unsigned j = 0; j < 16; ++j) { const unsigned c = xb_ld(&bar[XB_XCNT(j)]); sum += c; cnt += (c > 0u) ? 1u : 0u; mine = (j == x) ? c : mine; }
        if (sum == G) break;
        __builtin_amdgcn_s_sleep(1);
        if ((++sp & 255u) == 0u) { if (xb_ld(&bar[XB_TMO])) break; if (sp > XB_SPIN_CAP) { atomicAdd(&bar[XB_TMO], 1u); break; } }
    }
    nloc = mine > 0u ? mine : 1u; nx = cnt > 0u ? cnt : 1u;
}
__device__ __forceinline__ void xcd_barrier(const XcdBarrier& b) {
    asm volatile("s_waitcnt vmcnt(0)" ::: "memory");
    __syncthreads();
    if (threadIdx.x == 0) {
        unsigned* bar = b.bar; asm volatile("" : "+s"(bar));
        __builtin_amdgcn_s_waitcnt(0);
        unsigned nloc = b.st[0], nx = b.st[1];
        if (nloc == 0u) { xcd_barrier_complete(bar, b.x, nloc, nx); b.st[0] = nloc; b.st[1] = nx; }
        const unsigned old = xb_add(&bar[XB_XSUB(b.x)], 1u);
        const unsigned gen = old / nloc;
        if (old + 1u == (gen + 1u) * nloc) {
            __builtin_amdgcn_fence(__ATOMIC_RELEASE, "agent");
            asm volatile("s_waitcnt vmcnt(0)" ::: "memory");
            const unsigned og = xb_add(&bar[XB_TOP], 1u);
            const unsigned tg = og / nx;
            if (og + 1u == (tg + 1u) * nx) xb_add(&bar[XB_TOPGEN], 1u);
            else XB_SPIN(xb_ld(&bar[XB_TOPGEN]) == tg, bar);
            __builtin_amdgcn_fence(__ATOMIC_ACQUIRE, "agent");
            xb_add(&bar[XB_XGEN(b.x)], 1u);
            asm volatile("s_waitcnt vmcnt(0)" ::: "memory");
        } else {
            XB_SPIN(xb_ld(&bar[XB_XGEN(b.x)]) == gen, bar);
            __builtin_amdgcn_fence(__ATOMIC_ACQUIRE, "agent");
            asm volatile("s_waitcnt vmcnt(0)" ::: "memory");
        }
    }
    __syncthreads();
}

__device__ __forceinline__ float wave_sum(float v, int lane) {
#pragma unroll
    for (int o = 1; o < 64; o <<= 1) v += shx(v, o, lane);
    return v;
}
struct MapId { __device__ __forceinline__ int operator()(int d) const { return d; } };
struct MapFfnIn { __device__ __forceinline__ int operator()(int d) const { const int blk = d >> 8, r = d & 255, j = blk * 128 + (r & 127); return (r < 128) ? j : DFF + j; } };
struct MapMixIn { __device__ __forceinline__ int operator()(int d) const {
    if (d < 1024) return d; if (d < 6144) return d + 16; if (d < 6656) return d + 24; if (d < 6672) return 1024 + (d - 6656); if (d < 6680) return 6160 + (d - 6672); return -1; } };
template <class CM>
__device__ __forceinline__ void transpose_item(const float* W, int K, int Nsrc, bf16_t* WT, LAS float* scr, int kb, int nb, int lane, const CM cm) {
    const int k0 = 64 * kb, n0 = 32 * nb; const int sc = cm(n0 + (lane & 31));
#pragma unroll 8
    for (int i = 0; i < 32; ++i) { const int kk = 2 * i + (lane >> 5); scr[kk * 33 + (lane & 31)] = (sc >= 0) ? W[(size_t)(k0 + kk) * Nsrc + sc] : 0.f; }
    LDS_WAIT(); asm volatile("" ::: "memory");
    const int c = lane & 7;
#pragma unroll
    for (int j = 0; j < 4; ++j) { const int n = (lane >> 3) + 8 * j; const LAS float* s = scr + (8 * c) * 33 + n;
        u32x4 o; o.x = cvt_pk_bf16(s[0 * 33], s[1 * 33]); o.y = cvt_pk_bf16(s[2 * 33], s[3 * 33]); o.z = cvt_pk_bf16(s[4 * 33], s[5 * 33]); o.w = cvt_pk_bf16(s[6 * 33], s[7 * 33]);
        *(u32x4*)(WT + (size_t)(n0 + n) * K + k0 + 8 * c) = o; }
    LDS_WAIT(); asm volatile("" ::: "memory");
}
template <class CM>
__device__ __forceinline__ void transpose_matrix(const float* W, int K, int Nsrc, int Ndst, bf16_t* WT, LAS float* scr, int gw, int NGW, const CM cm) {
    const int lane = lane_id();
    const int nblk = Ndst / 32, items = (K / 64) * nblk;
    for (int it = gw; it < items; it += NGW) transpose_item(W, K, Nsrc, WT, scr, it / nblk, it % nblk, lane, cm);
}
__device__ __forceinline__ void cvt_copy(const float* src, bf16_t* dst, size_t n, size_t gt, size_t NGT) {
    for (size_t i = gt * 8; i < n; i += NGT * 8) { const f32x4 a = *(const f32x4*)(src + i), b = *(const f32x4*)(src + i + 4);
        u32x4 w; w.x = cvt_pk_bf16(a[0], a[1]); w.y = cvt_pk_bf16(a[2], a[3]); w.z = cvt_pk_bf16(b[0], b[1]); w.w = cvt_pk_bf16(b[2], b[3]); *(u32x4*)(dst + i) = w; }
}
__device__ __forceinline__ void ln_phase(float* Y, bf16_t* XB, const float* g, const float* b, int gw, int NGW) {
    const int lane = lane_id();
    f32x4 gv[8], bv[8];
#pragma unroll
    for (int j = 0; j < 8; ++j) { gv[j] = *(const f32x4*)(g + 4 * lane + 256 * j); bv[j] = *(const f32x4*)(b + 4 * lane + 256 * j); }
    for (int m = gw; m < M; m += NGW) {
        float* yr = Y + (size_t)m * D + 4 * lane; f32x4 v[8]; float s = 0.f;
#pragma unroll
        for (int j = 0; j < 8; ++j) { v[j] = *(const f32x4*)(yr + 256 * j); s += (v[j][0] + v[j][1]) + (v[j][2] + v[j][3]); }
        const float mean = wave_sum(s, lane) * (1.f / D); float s2 = 0.f;
#pragma unroll
        for (int j = 0; j < 8; ++j) { v[j] = v[j] - mean; s2 += (v[j][0] * v[j][0] + v[j][1] * v[j][1]) + (v[j][2] * v[j][2] + v[j][3] * v[j][3]); }
        const float rstd = 1.f / sqrtf(wave_sum(s2, lane) * (1.f / D) + LN_EPS);
        bf16_t* xr = XB + (size_t)m * D + 4 * lane;
#pragma unroll
        for (int j = 0; j < 8; ++j) { const f32x4 o = v[j] * rstd * gv[j] + bv[j]; *(f32x4*)(yr + 256 * j) = o;
            u32x2 w; w.x = cvt_pk_bf16(o[0], o[1]); w.y = cvt_pk_bf16(o[2], o[3]); *(u32x2*)(xr + 256 * j) = w; }
    }
}
struct XsOrder { int G, c;
    __device__ bool next(int i, pg8::Unit& u) const { const int L = i * G + c; if (L >= 512) return false; const int pml = L & 31, bh = L >> 5, b = bh >> 2, h = bh & 3;
        u.pm = L; u.pn = 0; u.aoff = (unsigned)(b * SEQ + pml * 256) * D + h * 512; u.boff = (unsigned)(b * NMEM) * D + h * 512; u.coff = (unsigned)(b * SEQ + pml * 256) * 1024 + h * 256; return true; } };
struct XpvOrder { int G, c;
    __device__ bool next(int i, pg8::Unit& u) const { const int L = i * G + c; if (L >= 1024) return false; const int pn = L & 1, pml = (L >> 1) & 31, bh = L >> 6, b = bh >> 2, h = bh & 3;
        u.pm = L; u.pn = pn; u.aoff = (unsigned)(b * SEQ + pml * 256) * 1024 + h * 256; u.boff = (unsigned)(h * 512 + pn * 256) * 1024 + b * NMEM; u.coff = (unsigned)(b * SEQ + pml * 256) * D + h * 512 + pn * 256; return true; } };

struct Args { const float* in[21]; float* out; unsigned char* ws; };
enum { I_X = 0, I_MEM, I_LNG, I_LNB, I_FWI, I_FWO, I_WIN, I_WOUT, I_GGW, I_GGB, I_GNG, I_HLB, I_HNG, I_DLAM, I_DNG, I_T5, I_MCW, I_MGB, I_XWQ, I_XWKV, I_XWO };

struct Ctx {
    LAS unsigned char* lds; int wave, G, bx, gw, NGW; unsigned* ctl; unsigned char* ws; float* out;
};

#define GRID_BAR() xcd_barrier(bar)
typedef __attribute__((address_space(4))) const Args* KArgsP;
__device__ __forceinline__ KArgsP kargs() { KArgsP p = (KArgsP)__builtin_amdgcn_kernarg_segment_ptr(); asm volatile("" : "+s"(p)); return p; }
#define ARG_IN(i) (kargs()->in[i])
#define ARG_OUT() (kargs()->out)
__device__ __forceinline__ int opq(int x) { asm volatile("" : "+s"(x)); return x; }

namespace mix {
constexpr int PJ = 72;
__device__ __forceinline__ f32x4 mma16(const LAS bf16_t* A, int lda, const LAS bf16_t* Bt, int ldb, int K, f32x4 acc, int lane) {
    const LAS bf16_t* ap = A + (lane & 15) * lda + 8 * (lane >> 4); const LAS bf16_t* bp = Bt + (lane & 15) * ldb + 8 * (lane >> 4);
    for (int k0 = 0; k0 < K; k0 += 32) { const bf16x8 a = *(const LAS bf16x8*)(ap + k0), b = *(const LAS bf16x8*)(bp + k0); acc = __builtin_amdgcn_mfma_f32_16x16x32_bf16(b, a, acc, 0, 0, 0); }
    return acc;
}
template <int CTRL, int RM, bool BC> __device__ __forceinline__ float dppf(float old, float x) {
    return __int_as_float(__builtin_amdgcn_update_dpp(__float_as_int(old), __float_as_int(x), CTRL, RM, 0xf, BC)); }
__device__ __forceinline__ float lane_prefix_sum(float x) {
    x += dppf<0x111, 0xf, true>(0.f, x); x += dppf<0x112, 0xf, true>(0.f, x); x += dppf<0x114, 0xf, true>(0.f, x); x += dppf<0x118, 0xf, true>(0.f, x);
    x += dppf<0x142, 0xa, false>(0.f, x); x += dppf<0x143, 0xc, false>(0.f, x); return x; }
__device__ __forceinline__ float lane_prefix_max(float x) {
    const float NI = -__builtin_inff();
    x = fmaxf(x, dppf<0x111, 0xf, false>(NI, x)); x = fmaxf(x, dppf<0x112, 0xf, false>(NI, x)); x = fmaxf(x, dppf<0x114, 0xf, false>(NI, x)); x = fmaxf(x, dppf<0x118, 0xf, false>(NI, x));
    x = fmaxf(x, dppf<0x142, 0xa, false>(NI, x)); x = fmaxf(x, dppf<0x143, 0xc, false>(NI, x)); return x; }
__device__ __forceinline__ float rdlane(float x, int l) { return __int_as_float(__builtin_amdgcn_readlane(__float_as_int(x), l)); }
__device__ __forceinline__ float wsum(float v, int lane) {
#pragma unroll
    for (int o = 1; o < 64; o <<= 1) v += shx(v, o, lane);
    return v;
}
__device__ __forceinline__ float expc(float x) { return fast_exp(fminf(x, 80.f)); }
typedef short v4i16_t __attribute__((ext_vector_type(4)));
__device__ __forceinline__ bf16x8 tr_frag(const LAS bf16_t* base, int pitch, int k0, int c0, int lane) {
    const LAS bf16_t* p = base + (k0 + 8 * (lane >> 4) + ((lane & 15) >> 2)) * pitch + c0 + 4 * (lane & 3);
    const s16x4 lo = __builtin_bit_cast(s16x4, __builtin_amdgcn_ds_read_tr16_b64_v4i16((LAS v4i16_t*)p));
    const s16x4 hi = __builtin_bit_cast(s16x4, __builtin_amdgcn_ds_read_tr16_b64_v4i16((LAS v4i16_t*)(p + 4 * pitch)));
    return (bf16x8){lo[0], lo[1], lo[2], lo[3], hi[0], hi[1], hi[2], hi[3]};
}
__device__ __forceinline__ f32x4 mma16_tb(const LAS bf16_t* A, int lda, const LAS bf16_t* X, int ldx, int n0, int K, f32x4 acc, int lane) {
    const LAS bf16_t* ap = A + (lane & 15) * lda + 8 * (lane >> 4);
    for (int k0 = 0; k0 < K; k0 += 32) { const bf16x8 a = *(const LAS bf16x8*)(ap + k0), b = tr_frag(X, ldx, k0, n0, lane); acc = __builtin_amdgcn_mfma_f32_16x16x32_bf16(b, a, acc, 0, 0, 0); }
    return acc;
}
__device__ __forceinline__ f32x4 mma16_tt(const LAS bf16_t* Y, int ldy, int m0, const LAS bf16_t* X, int ldx, int n0, int K, f32x4 acc, int lane) {
    for (int k0 = 0; k0 < K; k0 += 32) { const bf16x8 a = tr_frag(Y, ldy, k0, m0, lane), b = tr_frag(X, ldx, k0, n0, lane); acc = __builtin_amdgcn_mfma_f32_16x16x32_bf16(b, a, acc, 0, 0, 0); }
    return acc;
}
#define MIX_BAR() do { asm volatile("s_waitcnt vmcnt(0) lgkmcnt(0)" ::: "memory"); __builtin_amdgcn_s_barrier(); asm volatile("" ::: "memory"); } while (0)
#define MIX_LBAR() do { asm volatile("s_waitcnt lgkmcnt(0)" ::: "memory"); __builtin_amdgcn_s_barrier(); asm volatile("" ::: "memory"); } while (0)

template <int DK, bool HGRN>
__device__ __forceinline__ void gla_stream(LAS unsigned char* lds, int wave, int lane, const bf16_t* PROJ, const float* GATES, bf16_t* MIXED, int b, int h,
                                           const float* gate_w, const float* gate_b, const float* hlb0, const float* hlb1, int layer, const float* norm_g) {
    constexpr int P = DK + 8, PV = 136, CH = DK / 8, NQ = CH / 8, ND = DK / 16;
    LAS bf16_t* qa = (LAS bf16_t*)lds;
    LAS bf16_t* qb = qa + 64 * P;
    LAS bf16_t* ka = qb + 32 * P;
    LAS bf16_t* kb = ka + 32 * P;
    LAS bf16_t* ks = kb + 64 * P;
    LAS bf16_t* vv = ks + 64 * P;
    LAS bf16_t* ST = vv + 64 * PV;
    LAS bf16_t* at = ST + 128 * P;
    LAS float* dec = (LAS float*)(at + 64 * PJ);
    LAS float* rsum = dec + DK;
    LAS float* wg = rsum + 512;
    static_assert((size_t)((64 + 32 + 32 + 64 + 64 + 128) * P + 64 * PV + 64 * PJ) * 2 + (DK + 512 + 1100) * 4 <= 160 * 1024 - 1024, "stream LDS map");
    const int tid = wave * 64 + lane, d0 = wave * CH, fq = lane >> 4, fr = lane & 15;
    const bool lo = lane < 32;
    if (HGRN) { for (int i = tid; i < DK; i += 512) { const int c = h * DK + i; float lbv = 0.f; if (layer == 1) { lbv = sigmoidf_(hlb1[c] - hlb0[c]); lbv = fminf(fmaxf(lbv, 0.f), 1.f - 1e-6f); } wg[i] = lbv; } }
    else { for (int i = tid; i < 16 * 64; i += 512) wg[i] = gate_w[(i >> 6) * 256 + h * 64 + (i & 63)]; for (int i = tid; i < 64; i += 512) wg[1024 + i] = gate_b[h * 64 + i]; }
    for (int i = tid; i < 128 * P / 2; i += 512) ((LAS unsigned*)ST)[i] = 0u;
    f32x4 sacc[ND];
#pragma unroll
    for (int i = 0; i < ND; ++i) sacc[i] = (f32x4){0.f, 0.f, 0.f, 0.f};
    const f32x4 ng = *(const f32x4*)(norm_g + 16 * wave + 4 * fq);
    const int qcol = HGRN ? PQ_B + h * 128 + d0 : PQ_A + h * 64 + d0, kcol = HGRN ? PF_B + h * 128 + d0 : PK_A + h * 64 + d0;
    const int vcol = (HGRN ? PI_B : PV_A) + h * 128 + 16 * wave, gcol = (HGRN ? PG_B : PR_A) + h * 128 + 16 * wave + 4 * fq, ocol = (HGRN ? 512 : 0) + h * 128 + 16 * wave + 4 * fq;
    const size_t row0 = (size_t)b * SEQ;
    u32x4 rq[NQ], rk[NQ], rv[2]; f32x4 rl[4]; u32x2 gt[4];
#define GLA_LOAD(c) do { const bf16_t* pr = PROJ + (row0 + (size_t)(c) * 64 + lane) * NPROJ; \
        _Pragma("unroll") for (int i_ = 0; i_ < NQ; ++i_) { rq[i_] = *(const u32x4*)(pr + qcol + 8 * i_); rk[i_] = *(const u32x4*)(pr + kcol + 8 * i_); } \
        rv[0] = *(const u32x4*)(pr + vcol); rv[1] = *(const u32x4*)(pr + vcol + 8); \
        if (!HGRN) { const float* pg = GATES + (row0 + (size_t)(c) * 64 + lane) * 32; _Pragma("unroll") for (int i_ = 0; i_ < 4; ++i_) rl[i_] = *(const f32x4*)(pg + 4 * i_); } } while (0)
#define GLA_LOADG(c) do { _Pragma("unroll") for (int tt_ = 0; tt_ < 4; ++tt_) gt[tt_] = *(const u32x2*)(PROJ + (row0 + (size_t)(c) * 64 + 16 * tt_ + fr) * NPROJ + gcol); } while (0)
    GLA_LOAD(0); GLA_LOADG(0);
    MIX_BAR();
    for (int c = 0; c < SEQ / 64; ++c) {
        {
            float qv[CH], kv[CH], cum[CH];
#pragma unroll
            for (int i = 0; i < CH; ++i) {
                const unsigned wq = rq[i >> 3][(i >> 1) & 3], wk = rk[i >> 3][(i >> 1) & 3];
                const float qraw = (i & 1) ? bfhi(wq) : bflo(wq), kraw = (i & 1) ? bfhi(wk) : bflo(wk);
                float g;
                if (HGRN) { const float lbv = wg[d0 + i]; const float sg = sigmoidf_(kraw); g = __logf(fmaxf(lbv, 1e-12f) + (1.f - lbv) * sg); qv[i] = siluf_(qraw) * 0.08838834764831845f; kv[i] = (1.f - lbv) * (1.f - sg); }
                else { float a = wg[1024 + d0 + i];
#pragma unroll
                    for (int r = 0; r < 16; ++r) a += rl[r >> 2][r & 3] * wg[r * 64 + d0 + i];
                    g = logsigmoidf_(a) * 0.0625f; qv[i] = qraw * 0.125f; kv[i] = kraw; }
                cum[i] = lane_prefix_sum(g);
            }
            unsigned pqa[CH / 2], pq2[CH / 2], pkb[CH / 2], pks[CH / 2]; float decv = 0.f;
#pragma unroll
            for (int i = 0; i < CH; i += 2) {
                float e0[2], e2[2], ek[2], es[2];
#pragma unroll
                for (int j = 0; j < 2; ++j) { const float cm = cum[i + j], c31 = rdlane(cm, 31);
                    const float e1 = fast_exp(fmaxf(lo ? cm : cm - c31, -80.f)), k1 = fast_exp(fminf(c31 - cm, 80.f));
                    const float E0 = rdlane(e1, 31), E63 = fast_rcp(rdlane(k1, 63));
                    e0[j] = qv[i + j] * (lo ? e1 : e1 * E0); e2[j] = lo ? kv[i + j] * fast_rcp(e1) : qv[i + j] * e1; ek[j] = kv[i + j] * k1; es[j] = ek[j] * E63;
                    decv = (lane == i + j) ? E0 * E63 : decv; }
                pqa[i >> 1] = cvt_pk_bf16_c(e0[0], e0[1]); pq2[i >> 1] = cvt_pk_bf16_c(e2[0], e2[1]); pkb[i >> 1] = cvt_pk_bf16_c(ek[0], ek[1]); pks[i >> 1] = cvt_pk_bf16_c(es[0], es[1]);
            }
            if (lane < CH) dec[d0 + lane] = decv;
            LAS bf16_t* p2 = lo ? ka + lane * P + d0 : qb + (lane - 32) * P + d0;
#pragma unroll
            for (int i = 0; i < NQ; ++i) {
                *(LAS u32x4*)(qa + lane * P + d0 + 8 * i) = (u32x4){pqa[4 * i], pqa[4 * i + 1], pqa[4 * i + 2], pqa[4 * i + 3]};
                *(LAS u32x4*)(kb + lane * P + d0 + 8 * i) = (u32x4){pkb[4 * i], pkb[4 * i + 1], pkb[4 * i + 2], pkb[4 * i + 3]};
                *(LAS u32x4*)(ks + lane * P + d0 + 8 * i) = (u32x4){pks[4 * i], pks[4 * i + 1], pks[4 * i + 2], pks[4 * i + 3]};
                *(LAS u32x4*)(p2 + 8 * i) = (u32x4){pq2[4 * i], pq2[4 * i + 1], pq2[4 * i + 2], pq2[4 * i + 3]};
            }
            *(LAS u32x4*)(vv + lane * PV + 16 * wave) = rv[0]; *(LAS u32x4*)(vv + lane * PV + 16 * wave + 8) = rv[1];
        }
        if (c + 1 < SEQ / 64) GLA_LOAD(c + 1);
        MIX_LBAR();
        {
            const int ti = wave >> 1;
#pragma unroll
            for (int j = 0; j < 2; ++j) { const int tj = 2 * (wave & 1) + j; f32x4 a = (f32x4){0.f, 0.f, 0.f, 0.f};
                if (tj <= ti) { a = (ti < 2) ? mma16(qa + 16 * ti * P, P, ka + 16 * tj * P, P, DK, a, lane) : mma16(qb + 16 * (ti - 2) * P, P, kb + 16 * tj * P, P, DK, a, lane);
                    if (tj == ti) {
#pragma unroll
                        for (int r = 0; r < 4; ++r) if (4 * fq + r > fr) a[r] = 0.f; } }
                u32x2 w; w.x = cvt_pk_bf16_c(a[0], a[1]); w.y = cvt_pk_bf16_c(a[2], a[3]); *(LAS u32x2*)(at + (16 * ti + fr) * PJ + 16 * tj + 4 * fq) = w; }
        }
        f32x4 oacc[4];
#pragma unroll
        for (int tt = 0; tt < 4; ++tt) oacc[tt] = mma16(qa + 16 * tt * P, P, ST + 16 * wave * P, P, DK, (f32x4){0.f, 0.f, 0.f, 0.f}, lane);
        MIX_LBAR();
#pragma unroll
        for (int tt = 0; tt < 4; ++tt) oacc[tt] = mma16_tb(at + 16 * tt * PJ, PJ, vv, PV, 16 * wave, tt < 2 ? 32 : 64, oacc[tt], lane);
#pragma unroll
        for (int dt = 0; dt < ND; ++dt) { const f32x4 dv = *(const LAS f32x4*)(dec + 16 * dt + 4 * fq);
            sacc[dt] = mma16_tt(vv, PV, 16 * wave, ks, P, 16 * dt, 64, sacc[dt] * dv, lane);
            u32x2 w; w.x = cvt_pk_bf16_c(sacc[dt][0], sacc[dt][1]); w.y = cvt_pk_bf16_c(sacc[dt][2], sacc[dt][3]); *(LAS u32x2*)(ST + (16 * wave + fr) * P + 16 * dt + 4 * fq) = w; }
#pragma unroll
        for (int tt = 0; tt < 4; ++tt) { float s = (oacc[tt][0] * oacc[tt][0] + oacc[tt][1] * oacc[tt][1]) + (oacc[tt][2] * oacc[tt][2] + oacc[tt][3] * oacc[tt][3]);
            s += shx(s, 16, lane); s += shx(s, 32, lane); if (fq == 0) rsum[wave * 64 + 16 * tt + fr] = s; }
        MIX_LBAR();
#pragma unroll
        for (int tt = 0; tt < 4; ++tt) { float tot = 0.f;
#pragma unroll
            for (int w8 = 0; w8 < 8; ++w8) tot += rsum[w8 * 64 + 16 * tt + fr];
            const float rstd = 1.0f / sqrtf(tot * (1.f / 128.f) + LN_EPS);
            const float g0 = bflo(gt[tt].x), g1 = bfhi(gt[tt].x), g2 = bflo(gt[tt].y), g3 = bfhi(gt[tt].y);
            const f32x4 o = oacc[tt] * rstd * ng;
            u32x2 w; w.x = cvt_pk_bf16_c(o[0] * siluf_(g0), o[1] * siluf_(g1)); w.y = cvt_pk_bf16_c(o[2] * siluf_(g2), o[3] * siluf_(g3));
            *(u32x2*)(MIXED + (row0 + (size_t)c * 64 + 16 * tt + fr) * D + ocol) = w; }
        if (c + 1 < SEQ / 64) GLA_LOADG(c + 1);
    }
    MIX_BAR();
#undef GLA_LOAD
#undef GLA_LOADG
}

__device__ __forceinline__ void mlstm_stream(LAS unsigned char* lds, int wave, int lane, const bf16_t* PROJ, const float* GATES, bf16_t* MIXED, int b, int h, const float* conv_w, const float* gate_b) {
    constexpr int PV = 136;
    LAS bf16_t* q_ = (LAS bf16_t*)lds;
    LAS bf16_t* qh = q_ + 64 * PJ;
    LAS bf16_t* k_ = qh + 64 * PJ;
    LAS bf16_t* ks = k_ + 64 * PJ;
    LAS bf16_t* vv = ks + 64 * PJ;
    LAS bf16_t* CT = vv + 64 * PV;
    LAS bf16_t* sc = CT + 128 * PJ;
    LAS float* av = (LAS float*)(sc + 64 * PJ);
    LAS float* uv = av + 64;
    LAS float* mt = uv + 64;
    LAS float* nst = mt + 64;
    LAS float* qn = nst + 64;
    LAS float* rs = qn + 512;
    LAS float* cw = rs + 256;
    const int tid = wave * 64 + lane, d0 = wave * 8, fq = lane >> 4, fr = lane & 15;
    for (int i = tid; i < 512; i += 512) { const int part = i >> 8, d = (i >> 2) & 63, j = i & 3; cw[i] = conv_w[j * 512 + part * 256 + h * 64 + d]; }
    for (int i = tid; i < 64; i += 512) nst[i] = 0.f;
    for (int i = tid; i < 128 * PJ / 2; i += 512) ((LAS unsigned*)CT)[i] = 0u;
    const float bi = gate_b[h], bf = gate_b[4 + h];
    float m_st = 0.f;
    f32x4 cacc[4];
#pragma unroll
    for (int i = 0; i < 4; ++i) cacc[i] = (f32x4){0.f, 0.f, 0.f, 0.f};
    const size_t row0 = (size_t)b * SEQ;
    const int qcol = PQ_D + h * 64 + d0, kcol = PK_D + h * 64 + d0, vcol = PV_D + h * 128 + 16 * wave, gcol = PO_D + h * 128 + 16 * wave + 4 * fq, ocol = 1536 + h * 128 + 16 * wave + 4 * fq;
    u32x4 rq[4], rk[4], rv[2]; float gi, gf; u32x2 gt[4];
#define ML_LOAD(c) do { const int t_ = (c) * 64 + lane; \
        _Pragma("unroll") for (int j_ = 0; j_ < 4; ++j_) { if (t_ - j_ >= 0) { const bf16_t* pr = PROJ + (row0 + (size_t)(t_ - j_)) * NPROJ; rq[j_] = *(const u32x4*)(pr + qcol); rk[j_] = *(const u32x4*)(pr + kcol); } \
            else { rq[j_] = (u32x4){0u, 0u, 0u, 0u}; rk[j_] = (u32x4){0u, 0u, 0u, 0u}; } } \
        { const bf16_t* pr = PROJ + (row0 + (size_t)t_) * NPROJ; rv[0] = *(const u32x4*)(pr + vcol); rv[1] = *(const u32x4*)(pr + vcol + 8); const float* pg = GATES + (row0 + (size_t)t_) * 32; gi = pg[16 + h]; gf = pg[20 + h]; } } while (0)
#define ML_LOADG(c) do { _Pragma("unroll") for (int tt_ = 0; tt_ < 4; ++tt_) gt[tt_] = *(const u32x2*)(PROJ + (row0 + (size_t)(c) * 64 + 16 * tt_ + fr) * NPROJ + gcol); } while (0)
    ML_LOAD(0); ML_LOADG(0);
    MIX_BAR();
    for (int c = 0; c < SEQ / 64; ++c) {
        float dec_c;
        {
            const float li = gi + bi, lf = logsigmoidf_(gf + bf);
            const float cum = lane_prefix_sum(lf), a = li - cum, pm = lane_prefix_max(a), u = fmaxf(m_st, pm);
            const float w_inter = fast_exp(m_st - u), u63 = rdlane(u, 63), cum63 = rdlane(cum, 63), wk = fast_exp(a - u63);
            dec_c = fast_exp(m_st - u63);
            if (wave == 0) { av[lane] = a; uv[lane] = u; mt[lane] = cum + u; }
            float qc[8], kc[8];
#pragma unroll
            for (int i = 0; i < 8; ++i) { const f32x4 wq4 = *(const LAS f32x4*)(cw + (d0 + i) * 4), wk4 = *(const LAS f32x4*)(cw + 256 + (d0 + i) * 4); float sq = 0.f, sk = 0.f;
#pragma unroll
                for (int j = 0; j < 4; ++j) { const unsigned wq = rq[j][i >> 1], wkk = rk[j][i >> 1]; const float xq = (i & 1) ? bfhi(wq) : bflo(wq), xk = (i & 1) ? bfhi(wkk) : bflo(wkk);
                    sq += wq4[3 - j] * xq; sk += wk4[3 - j] * xk; }
                qc[i] = siluf_(sq); kc[i] = siluf_(sk) * 0.125f; }
            float qnp = 0.f, nnew = 0.f; unsigned pq[4], ph[4], pk[4], pw[4];
#pragma unroll
            for (int i = 0; i < 8; i += 2) { pq[i >> 1] = cvt_pk_bf16_c(qc[i], qc[i + 1]); ph[i >> 1] = cvt_pk_bf16_c(qc[i] * w_inter, qc[i + 1] * w_inter); pk[i >> 1] = cvt_pk_bf16_c(kc[i], kc[i + 1]);
                pw[i >> 1] = cvt_pk_bf16_c(kc[i] * wk, kc[i + 1] * wk); }
#pragma unroll
            for (int i = 0; i < 8; ++i) { const float nold = nst[d0 + i]; qnp += qc[i] * w_inter * nold;
                const float nsum = rdlane(lane_prefix_sum(kc[i] * wk), 63); nnew = (lane == i) ? dec_c * nold + nsum : nnew; }
            if (lane < 8) nst[d0 + lane] = nnew;
            qn[wave * 64 + lane] = qnp;
            *(LAS u32x4*)(q_ + lane * PJ + d0) = (u32x4){pq[0], pq[1], pq[2], pq[3]};
            *(LAS u32x4*)(qh + lane * PJ + d0) = (u32x4){ph[0], ph[1], ph[2], ph[3]};
            *(LAS u32x4*)(k_ + lane * PJ + d0) = (u32x4){pk[0], pk[1], pk[2], pk[3]};
            *(LAS u32x4*)(ks + lane * PJ + d0) = (u32x4){pw[0], pw[1], pw[2], pw[3]};
            *(LAS u32x4*)(vv + lane * PV + 16 * wave) = rv[0]; *(LAS u32x4*)(vv + lane * PV + 16 * wave + 8) = rv[1];
            m_st = cum63 + u63;
        }
        if (c + 1 < SEQ / 64) ML_LOAD(c + 1);
        MIX_LBAR();
        {
            const int ti = wave >> 1;
#pragma unroll
            for (int j = 0; j < 2; ++j) { const int tj = 2 * (wave & 1) + j; f32x4 a = (f32x4){0.f, 0.f, 0.f, 0.f};
                if (tj <= ti) { a = mma16(q_ + 16 * ti * PJ, PJ, k_ + 16 * tj * PJ, PJ, 64, a, lane);
                    const float ui = uv[16 * ti + fr]; const f32x4 aj = *(const LAS f32x4*)(av + 16 * tj + 4 * fq);
#pragma unroll
                    for (int r = 0; r < 4; ++r) a[r] = (16 * tj + 4 * fq + r <= 16 * ti + fr) ? a[r] * fast_exp(aj[r] - ui) : 0.f; }
                float s = (a[0] + a[1]) + (a[2] + a[3]); s += shx(s, 16, lane); s += shx(s, 32, lane); if (fq == 0) rs[tj * 64 + 16 * ti + fr] = s;
                u32x2 w; w.x = cvt_pk_bf16_c(a[0], a[1]); w.y = cvt_pk_bf16_c(a[2], a[3]); *(LAS u32x2*)(sc + (16 * ti + fr) * PJ + 16 * tj + 4 * fq) = w; }
        }
        f32x4 oacc[4];
#pragma unroll
        for (int tt = 0; tt < 4; ++tt) oacc[tt] = mma16(qh + 16 * tt * PJ, PJ, CT + 16 * wave * PJ, PJ, 64, (f32x4){0.f, 0.f, 0.f, 0.f}, lane);
        MIX_LBAR();
#pragma unroll
        for (int tt = 0; tt < 4; ++tt) oacc[tt] = mma16_tb(sc + 16 * tt * PJ, PJ, vv, PV, 16 * wave, tt < 2 ? 32 : 64, oacc[tt], lane);
#pragma unroll
        for (int dt = 0; dt < 4; ++dt) { cacc[dt] = mma16_tt(vv, PV, 16 * wave, ks, PJ, 16 * dt, 64, cacc[dt] * dec_c, lane);
            u32x2 w; w.x = cvt_pk_bf16_c(cacc[dt][0], cacc[dt][1]); w.y = cvt_pk_bf16_c(cacc[dt][2], cacc[dt][3]); *(LAS u32x2*)(CT + (16 * wave + fr) * PJ + 16 * dt + 4 * fq) = w; }
#pragma unroll
        for (int tt = 0; tt < 4; ++tt) { const int i = 16 * tt + fr; float den = 0.f;
#pragma unroll
            for (int w8 = 0; w8 < 8; ++w8) den += qn[w8 * 64 + i];
            den += (rs[i] + rs[64 + i]) + (rs[128 + i] + rs[192 + i]);
            const float inv = 1.0f / fmaxf(fabsf(den), fast_exp(-mt[i]));
            const float g0 = bflo(gt[tt].x), g1 = bfhi(gt[tt].x), g2 = bflo(gt[tt].y), g3 = bfhi(gt[tt].y);
            u32x2 w; w.x = cvt_pk_bf16_c(oacc[tt][0] * inv * sigmoidf_(g0), oacc[tt][1] * inv * sigmoidf_(g1)); w.y = cvt_pk_bf16_c(oacc[tt][2] * inv * sigmoidf_(g2), oacc[tt][3] * inv * sigmoidf_(g3));
            *(u32x2*)(MIXED + (row0 + (size_t)c * 64 + i) * D + ocol) = w; }
        if (c + 1 < SEQ / 64) ML_LOADG(c + 1);
        MIX_LBAR();
    }
    MIX_BAR();
#undef ML_LOAD
#undef ML_LOADG
}

constexpr int KP = 136, VP = 160, KT_BYTES = 64 * KP * 2, VT_BYTES = 64 * VP * 2, AT_BUF = KT_BYTES + VT_BYTES;
__device__ __forceinline__ int crow(int r, int hi) { return (r & 3) + 8 * (r >> 2) + 4 * hi; }
__device__ __forceinline__ void diff_unit(LAS unsigned char* lds, int wave, int lane, const bf16_t* PROJ, bf16_t* MIXED, int b, int h, int qb, const float* t5, float lam, const float* norm_g, float out_scale) {
    typedef short v4i16_t __attribute__((ext_vector_type(4)));
    LAS float* btab = (LAS float*)(lds + 2 * AT_BUF);
    LAS float* xch = (LAS float*)lds;
    const int tid = wave * 64 + lane, r32 = lane & 31, hi = lane >> 5, s = wave >> 2, wq = wave & 3;
    const int q0 = qb * 128, NT = 2 * qb + 2;
    const size_t row0 = (size_t)b * SEQ;
    if (tid < 128) { const int n = tid; int bk; if (n < 16) bk = n; else { bk = 16 + (int)(__logf((float)n * 0.0625f) / 2.0794415416798357f * 16.0f); bk = bk < 16 ? 16 : (bk > 31 ? 31 : bk); }
        btab[n] = (t5[bk * 4 + h] - t5[31 * 4 + h]) * LOG2E; }
    bf16x8 qr[4];
    { const bf16_t* qp = PROJ + (row0 + q0 + 32 * wq + r32) * NPROJ + PQ_C + h * 128 + 64 * s + 8 * hi;
#pragma unroll
        for (int d = 0; d < 4; ++d) qr[d] = *(const bf16x8*)(qp + 16 * d); }
    const int srow = tid >> 4, scol = (tid & 15) * 8;
    const bf16_t* kg = PROJ + (row0 + srow) * NPROJ + PK_C + h * 128 + scol; const bf16_t* vg = PROJ + (row0 + srow) * NPROJ + PV_C + h * 128 + scol;
    u32x4 sk[2], sv[2];
#define AT_LOAD(t) do { sk[0] = *(const u32x4*)(kg + (size_t)(64 * (t)) * NPROJ); sk[1] = *(const u32x4*)(kg + (size_t)(64 * (t) + 32) * NPROJ); \
                        sv[0] = *(const u32x4*)(vg + (size_t)(64 * (t)) * NPROJ); sv[1] = *(const u32x4*)(vg + (size_t)(64 * (t) + 32) * NPROJ); } while (0)
#define AT_STORE(buf) do { LAS bf16_t* kt_ = (LAS bf16_t*)(lds + (buf) * AT_BUF); LAS bf16_t* vt_ = (LAS bf16_t*)(lds + (buf) * AT_BUF + KT_BYTES); \
                        *(LAS u32x4*)(kt_ + srow * KP + scol) = sk[0]; *(LAS u32x4*)(kt_ + (srow + 32) * KP + scol) = sk[1]; \
                        *(LAS u32x4*)(vt_ + srow * VP + scol) = sv[0]; *(LAS u32x4*)(vt_ + (srow + 32) * VP + scol) = sv[1]; } while (0)
    AT_LOAD(0); AT_STORE(0);
    MIX_BAR();
    f32x16 o[4];
#pragma unroll
    for (int i = 0; i < 4; ++i)
#pragma unroll
        for (int r = 0; r < 16; ++r) o[i][r] = 0.f;
    float m_run = -1.0e30f, l_run = 0.f;
    const int qpos = q0 + 32 * wq + r32;
    constexpr float SC = 0.125f * LOG2E;
    for (int t = 0; t < NT; ++t) {
        const int buf = t & 1;
        if (t + 1 < NT) AT_LOAD(t + 1);
        const LAS bf16_t* kt_ = (const LAS bf16_t*)(lds + buf * AT_BUF); const LAS bf16_t* vt_ = (const LAS bf16_t*)(lds + buf * AT_BUF + KT_BYTES);
        f32x16 p0, p1;
#pragma unroll
        for (int r = 0; r < 16; ++r) { p0[r] = 0.f; p1[r] = 0.f; }
        { const LAS bf16_t* kp = kt_ + r32 * KP + 64 * s + 8 * hi;
#pragma unroll
            for (int d = 0; d < 4; ++d) { const bf16x8 k0 = *(const LAS bf16x8*)(kp + 16 * d), k1 = *(const LAS bf16x8*)(kp + 32 * KP + 16 * d);
                p0 = __builtin_amdgcn_mfma_f32_32x32x16_bf16(k0, qr[d], p0, 0, 0, 0); p1 = __builtin_amdgcn_mfma_f32_32x32x16_bf16(k1, qr[d], p1, 0, 0, 0); } }
        if (t >= NT - 4) {
            const int kbase = 64 * t - qpos;
#pragma unroll
            for (int r = 0; r < 16; ++r) { const int rel0 = -(kbase + crow(r, hi)), rel1 = rel0 - 32;
                p0[r] = (rel0 >= 0) ? p0[r] * SC + btab[rel0 > 127 ? 127 : rel0] : -1.0e30f;
                p1[r] = (rel1 >= 0) ? p1[r] * SC + btab[rel1 > 127 ? 127 : rel1] : -1.0e30f; }
        } else {
#pragma unroll
            for (int r = 0; r < 16; ++r) { p0[r] *= SC; p1[r] *= SC; }
        }
        float mx = fmaxf(p0[0], p1[0]);
#pragma unroll
        for (int r = 1; r < 16; ++r) mx = fmaxf(mx, fmaxf(p0[r], p1[r]));
        mx = fmaxf(mx, shx(mx, 32, lane));
        const float m_new = fmaxf(m_run, mx), alpha = fast_exp2(m_run - m_new); m_run = m_new;
        float ps = 0.f;
#pragma unroll
        for (int r = 0; r < 16; ++r) { p0[r] = fast_exp2(p0[r] - m_new); p1[r] = fast_exp2(p1[r] - m_new); ps += p0[r] + p1[r]; }
        l_run = l_run * alpha + ps;
#pragma unroll
        for (int i = 0; i < 4; ++i)
#pragma unroll
            for (int r = 0; r < 16; ++r) o[i][r] *= alpha;
        bf16x8 pf[4];
#pragma unroll
        for (int ks = 0; ks < 4; ++ks) { unsigned w[4];
#pragma unroll
            for (int j = 0; j < 4; ++j) { const int r = 8 * (ks & 1) + 2 * j; w[j] = (ks < 2) ? cvt_pk_bf16_c(p0[r], p0[r + 1]) : cvt_pk_bf16_c(p1[r], p1[r + 1]); }
            pf[ks] = __builtin_bit_cast(bf16x8, (u32x4){w[0], w[1], w[2], w[3]}); }
        const LAS bf16_t* vp = vt_ + (4 * hi + ((lane & 15) >> 2)) * VP + 16 * ((lane >> 4) & 1) + 4 * (lane & 3);
#pragma unroll
        for (int ks = 0; ks < 4; ++ks)
#pragma unroll
            for (int blk = 0; blk < 4; ++blk) {
                const s16x4 lo = __builtin_bit_cast(s16x4, __builtin_amdgcn_ds_read_tr16_b64_v4i16((LAS v4i16_t*)(vp + (16 * ks) * VP + 32 * blk)));
                const s16x4 hh = __builtin_bit_cast(s16x4, __builtin_amdgcn_ds_read_tr16_b64_v4i16((LAS v4i16_t*)(vp + (16 * ks + 8) * VP + 32 * blk)));
                const bf16x8 vf = (bf16x8){lo[0], lo[1], lo[2], lo[3], hh[0], hh[1], hh[2], hh[3]};
                o[blk] = __builtin_amdgcn_mfma_f32_32x32x16_bf16(vf, pf[ks], o[blk], 0, 0, 0);
            }
        if (t + 1 < NT) AT_STORE(buf ^ 1);
        MIX_BAR();
    }
    const float l_tot = l_run + shx(l_run, 32, lane), inv = 1.0f / l_tot;
    if (s == 1) {
#pragma unroll
        for (int i = 0; i < 4; ++i)
#pragma unroll
            for (int r = 0; r < 16; ++r) xch[(wq * 64 + i * 16 + r) * 64 + lane] = o[i][r] * inv;
    }
    MIX_LBAR();
    if (s == 0) {
        float ss = 0.f;
#pragma unroll
        for (int i = 0; i < 4; ++i)
#pragma unroll
            for (int r = 0; r < 16; ++r) { const float v = o[i][r] * inv - lam * xch[(wq * 64 + i * 16 + r) * 64 + lane]; o[i][r] = v; ss += v * v; }
        ss += shx(ss, 32, lane);
        const float rstd = out_scale / sqrtf(ss * (1.f / 128.f) + LN_EPS);
        bf16_t* op = MIXED + (row0 + qpos) * D + 1024 + h * 128;
#pragma unroll
        for (int i = 0; i < 4; ++i)
#pragma unroll
            for (int g = 0; g < 4; ++g) { const int e = 32 * i + 8 * g + 4 * hi; const f32x4 gn = *(const f32x4*)(norm_g + e);
                u32x2 w; w.x = cvt_pk_bf16_c(o[i][4 * g] * rstd * gn[0], o[i][4 * g + 1] * rstd * gn[1]); w.y = cvt_pk_bf16_c(o[i][4 * g + 2] * rstd * gn[2], o[i][4 * g + 3] * rstd * gn[3]);
                *(u32x2*)(op + e) = w; }
    }
    MIX_LBAR();
#undef AT_LOAD
#undef AT_STORE
}
}

template <int l>
__device__ __forceinline__ void mixer_phase(const Ctx& C) {
    const int lane = lane_id(); int wave = C.wave; asm volatile("" : "+s"(wave));
    const bf16_t* PROJ = (const bf16_t*)(C.ws + WS_UNION); const float* GATES = (const float*)(C.ws + WS_GATES); bf16_t* MIXED = (bf16_t*)(C.ws + WS_MIXED);
    int bx = C.bx; asm volatile("" : "+s"(bx));
    if (bx < 16) mix::gla_stream<64, false>(C.lds, wave, lane, PROJ, GATES, MIXED, bx >> 2, bx & 3, ARG_IN(I_GGW) + l * 16 * 256, ARG_IN(I_GGB) + l * 256, nullptr, nullptr, l, ARG_IN(I_GNG) + l * 128);
    else if (bx < 32) mix::gla_stream<128, true>(C.lds, wave, lane, PROJ, GATES, MIXED, (bx - 16) >> 2, bx & 3, nullptr, nullptr, ARG_IN(I_HLB), ARG_IN(I_HLB) + 512, l, ARG_IN(I_HNG) + l * 128);
    else if (bx < 48) mix::mlstm_stream(C.lds, wave, lane, PROJ, GATES, MIXED, (bx - 32) >> 2, bx & 3, ARG_IN(I_MCW) + l * 4 * 512, ARG_IN(I_MGB) + l * 8);
    const float lambda_init = (l == 0) ? 0.2f : 0.35550906759096934f;
    float lam;
    { const float* dl = ARG_IN(I_DLAM) + l * 256; const float s1 = mix::wsum(dl[lane] * dl[64 + lane], lane), s2 = mix::wsum(dl[128 + lane] * dl[192 + lane], lane); lam = __expf(s1) - __expf(s2) + lambda_init; }
    LAS unsigned* wq = (LAS unsigned*)(C.lds + LDSCTL_OFF + 64);
    unsigned* ctr = C.ctl + CW_WQ + 64 * l;
    for (;;) {
        if (wave == 0 && lane == 0) *wq = __hip_atomic_fetch_add(ctr, 1u, __ATOMIC_RELAXED, __HIP_MEMORY_SCOPE_AGENT);
        MIX_BAR();
        const unsigned u = *wq;
        MIX_LBAR();
        if (u >= 1024u) break;
        mix::diff_unit(C.lds, wave, lane, PROJ, MIXED, (int)(u & 15u) >> 2, (int)(u & 3u), 63 - (int)(u >> 4), ARG_IN(I_T5), lam, ARG_IN(I_DNG) + l * 128, 1.0f - lambda_init);
    }
}

__device__ __forceinline__ void ffn_block(const Ctx& C, const XcdBarrier& bar, const bf16_t* wfi, const bf16_t* wfo, const float* xres, const float* lng, const float* lnb) {
    bf16_t* XB = (bf16_t*)(C.ws + WS_XB); bf16_t* H = (bf16_t*)(C.ws + WS_UNION);
    {
        pg8::Gemm g{XB, wfi}; pg8::StaticOrder S; S.init(M, 2 * DFF, opq(C.G), opq(C.bx), D, D, DFF, 128);
        pg8::EpiSwiGLU E{H, DFF};
        pg8::gemm_phase<D, D, D>(C.lds, C.wave, g, S, E);
    }
    GRID_BAR();
    {
        pg8::Gemm g{H, wfo}; pg8::StaticOrder S; S.init(M, D, opq(C.G), opq(C.bx), DFF, DFF, D, 256);
        pg8::EpiRes E{xres, C.out, 0.5f};
        pg8::gemm_phase<DFF, DFF, DFF>(C.lds, C.wave, g, S, E);
    }
    GRID_BAR();
    ln_phase(C.out, XB, lng, lnb, C.gw, C.NGW);
    GRID_BAR();
}

template <int l> __device__ __forceinline__ void layer_body(const Ctx& C, const XcdBarrier& bar) {
    unsigned char* ws = C.ws; bf16_t* XB = (bf16_t*)(ws + WS_XB);
        const float* lng = ARG_IN(I_LNG) + (size_t)l * 4 * D; const float* lnb = ARG_IN(I_LNB) + (size_t)l * 4 * D;
        ffn_block(C, bar, (const bf16_t*)(ws + WS_WFI + (size_t)(l * 2 + 0) * SZ_WFI), (const bf16_t*)(ws + WS_WFO + (size_t)(l * 2 + 0) * SZ_WFO),
                  l == 0 ? ARG_IN(I_X) : (const float*)ARG_OUT(), lng, lnb);
        {
            pg8::Gemm g{XB, (const bf16_t*)(ws + WS_WMI + l * SZ_WMI)}; pg8::StaticOrder S; S.init(M, NPROJ, opq(C.G), opq(C.bx), D, D, NPROJ, 256);
            pg8::EpiBf16 E{(bf16_t*)(ws + WS_UNION), NPROJ, 1.0f, (float*)(ws + WS_GATES), 26};
            pg8::gemm_phase<D, D, D>(C.lds, C.wave, g, S, E);
        }
        GRID_BAR();
        mixer_phase<l>(C);
        GRID_BAR();
        {
            pg8::Gemm g{(const bf16_t*)(ws + WS_MIXED), (const bf16_t*)(ws + WS_WMO + l * SZ_WDD)}; pg8::StaticOrder S; S.init(M, D, opq(C.G), opq(C.bx), D, D, D, 256);
            pg8::EpiRes E{ARG_OUT(), ARG_OUT(), 1.0f};
            pg8::gemm_phase<D, D, D>(C.lds, C.wave, g, S, E);
        }
        GRID_BAR();
        ln_phase(ARG_OUT(), XB, lng + D, lnb + D, C.gw, C.NGW);
        GRID_BAR();
        {
            pg8::Gemm g{XB, (const bf16_t*)(ws + WS_WXQ + l * SZ_WDD)}; pg8::StaticOrder S; S.init(M, D, opq(C.G), opq(C.bx), D, D, D, 256);
            pg8::EpiBf16 E{(bf16_t*)(ws + WS_UNION + UN_Q), D, 0.04419417382415922f * LOG2E, nullptr, -1};
            pg8::gemm_phase<D, D, D>(C.lds, C.wave, g, S, E);
        }
        GRID_BAR();
        {
            pg8::Gemm g{(const bf16_t*)(ws + WS_UNION + UN_Q), (const bf16_t*)(ws + WS_KB + (size_t)l * BATCH * NMEM * D * 2)}; XsOrder S{opq(C.G), opq(C.bx)};
            pg8::EpiSoftmax E{(bf16_t*)(ws + WS_UNION + UN_P), 1024};
            pg8::gemm_phase<D, D, 512>(C.lds, C.wave, g, S, E);
        }
        GRID_BAR();
        {
            pg8::Gemm g{(const bf16_t*)(ws + WS_UNION + UN_P), (const bf16_t*)(ws + WS_VT + (size_t)l * BATCH * NMEM * D * 2)}; XpvOrder S{opq(C.G), opq(C.bx)};
            pg8::EpiBf16 E{(bf16_t*)(ws + WS_UNION + UN_O), D, 1.0f, nullptr, -1};
            pg8::gemm_phase<1024, 1024, 256>(C.lds, C.wave, g, S, E);
        }
        GRID_BAR();
        {
            pg8::Gemm g{(const bf16_t*)(ws + WS_UNION + UN_O), (const bf16_t*)(ws + WS_WXO + l * SZ_WDD)}; pg8::StaticOrder S; S.init(M, D, opq(C.G), opq(C.bx), D, D, D, 256);
            pg8::EpiRes E{ARG_OUT(), ARG_OUT(), 1.0f};
            pg8::gemm_phase<D, D, D>(C.lds, C.wave, g, S, E);
        }
        GRID_BAR();
        ln_phase(ARG_OUT(), XB, lng + 2 * D, lnb + 2 * D, C.gw, C.NGW);
        GRID_BAR();
        ffn_block(C, bar, (const bf16_t*)(ws + WS_WFI + (size_t)(l * 2 + 1) * SZ_WFI), (const bf16_t*)(ws + WS_WFO + (size_t)(l * 2 + 1) * SZ_WFO),
                  (const float*)ARG_OUT(), lng + 3 * D, lnb + 3 * D);
}

__global__ void __launch_bounds__(NWAVES * 64, 2) hybrid_fwd(Args args) {
    extern __shared__ __attribute__((aligned(16))) unsigned char lds_raw[];
    Ctx C;
    C.lds = (LAS unsigned char*)lds_raw;
    C.wave = __builtin_amdgcn_readfirstlane(threadIdx.x >> 6);
    C.G = gridDim.x; C.bx = blockIdx.x; C.gw = C.bx * NWAVES + C.wave; C.NGW = C.G * NWAVES;
    C.ws = args.ws; C.out = ARG_OUT(); C.ctl = (unsigned*)(args.ws + WS_CTL);
    volatile LAS unsigned* MISC = (volatile LAS unsigned*)(C.lds + MISC_OFF);
    for (int u = threadIdx.x; u < 128; u += NWAVES * 64) ((LAS unsigned*)(C.lds + LDSCTL_OFF))[u] = 0u;
    __syncthreads();
    XcdBarrier bar = xcd_barrier_post(C.ctl + CW_BAR, MISC + 8);
    unsigned char* ws = args.ws;
    bf16_t* XB = (bf16_t*)(ws + WS_XB); bf16_t* MEMB = (bf16_t*)(ws + WS_MEMB);

    {
        LAS float* scr = (LAS float*)(C.lds + C.wave * 16384);
        for (int lj = 0; lj < 4; ++lj) {
            transpose_matrix(ARG_IN(I_FWI) + (size_t)lj * D * 2 * DFF, D, 2 * DFF, 2 * DFF, (bf16_t*)(ws + WS_WFI + lj * SZ_WFI), scr, C.gw, C.NGW, MapFfnIn());
            transpose_matrix(ARG_IN(I_FWO) + (size_t)lj * DFF * D, DFF, D, D, (bf16_t*)(ws + WS_WFO + lj * SZ_WFO), scr, C.gw, C.NGW, MapId());
        }
        for (int l = 0; l < DEPTH; ++l) {
            transpose_matrix(ARG_IN(I_WIN) + (size_t)l * D * NIN, D, NIN, NPROJ, (bf16_t*)(ws + WS_WMI + l * SZ_WMI), scr, C.gw, C.NGW, MapMixIn());
            transpose_matrix(ARG_IN(I_WOUT) + (size_t)l * D * D, D, D, D, (bf16_t*)(ws + WS_WMO + l * SZ_WDD), scr, C.gw, C.NGW, MapId());
            transpose_matrix(ARG_IN(I_XWQ) + (size_t)l * D * D, D, D, D, (bf16_t*)(ws + WS_WXQ + l * SZ_WDD), scr, C.gw, C.NGW, MapId());
            transpose_matrix(ARG_IN(I_XWKV) + (size_t)l * D * 2 * D, D, 2 * D, 2 * D, (bf16_t*)(ws + WS_WXKV + l * SZ_WKV), scr, C.gw, C.NGW, MapId());
            transpose_matrix(ARG_IN(I_XWO) + (size_t)l * D * D, D, D, D, (bf16_t*)(ws + WS_WXO + l * SZ_WDD), scr, C.gw, C.NGW, MapId());
        }
        const size_t gt = (size_t)C.bx * (NWAVES * 64) + C.wave * 64 + lane_id(), NGT = (size_t)C.G * (NWAVES * 64);
        cvt_copy(ARG_IN(I_X), XB, (size_t)M * D, gt, NGT);
        cvt_copy(ARG_IN(I_MEM), MEMB, (size_t)BATCH * NMEM * D, gt, NGT);
    }
    GRID_BAR();
    for (int l = 0; l < DEPTH; ++l) {
        const bf16_t* wkv = (const bf16_t*)(ws + WS_WXKV + l * SZ_WKV);
        {
            pg8::Gemm g{MEMB, wkv}; pg8::StaticOrder S; S.init(BATCH * NMEM, D, opq(C.G), opq((C.bx + C.G - 64 * l) % C.G), D, D, D, 256);
            pg8::EpiBf16 E{(bf16_t*)(ws + WS_KB + (size_t)l * BATCH * NMEM * D * 2), D, 1.0f, nullptr, -1};
            pg8::gemm_phase<D, D, D>(C.lds, C.wave, g, S, E);
        }
        {
            pg8::Gemm g{wkv + (size_t)D * D, MEMB}; pg8::StaticOrder S; S.init(D, BATCH * NMEM, opq(C.G), opq((C.bx + C.G - 64 * l - 32) % C.G), D, D, BATCH * NMEM, 256);
            pg8::EpiBf16 E{(bf16_t*)(ws + WS_VT + (size_t)l * BATCH * NMEM * D * 2), BATCH * NMEM, 1.0f, nullptr, -1};
            pg8::gemm_phase<D, D, D>(C.lds, C.wave, g, S, E);
        }
    }
    GRID_BAR();

    layer_body<0>(C, bar);
    layer_body<1>(C, bar);
}

extern "C" void kernel_launch(void* const* d_in, const int* in_sizes, int n_in, void* d_out, int out_size, void* d_ws, size_t ws_size, hipStream_t stream) {
    static int grid = 0;
    if (grid == 0) {
        if (n_in != 21 || out_size != M * D || ws_size < WS_END) { fprintf(stderr, "kernel_launch: unexpected problem (n_in %d out %d ws %zu, need %zu)\n", n_in, out_size, ws_size, (size_t)WS_END); grid = -1; return; }
        int dev = 0, cus = 0, per_cu = 0;
        if (hipGetDevice(&dev) != hipSuccess || hipDeviceGetAttribute(&cus, hipDeviceAttributeMultiprocessorCount, dev) != hipSuccess) { grid = -1; return; }
        if (hipFuncSetAttribute((const void*)hybrid_fwd, hipFuncAttributeMaxDynamicSharedMemorySize, LDS_BYTES) != hipSuccess) { fprintf(stderr, "kernel_launch: hipFuncSetAttribute failed\n"); grid = -1; return; }
        if (hipOccupancyMaxActiveBlocksPerMultiprocessor(&per_cu, (const void*)hybrid_fwd, NWAVES * 64, LDS_BYTES) != hipSuccess || per_cu < 1) { fprintf(stderr, "kernel_launch: occupancy query says %d\n", per_cu); (void)hipGetLastError(); grid = -1; return; }
        grid = cus;
    }
    if (grid < 0) return;
    if (hipMemsetAsync((char*)d_ws + WS_CTL, 0, CTL_ZERO_BYTES, stream) != hipSuccess) return;
    Args a{};
    for (int i = 0; i < 21; ++i) a.in[i] = (const float*)d_in[i];
    a.out = (float*)d_out; a.ws = (unsigned char*)d_ws;
    hipLaunchKernelGGL(hybrid_fwd, dim3(grid), dim3(NWAVES * 64), LDS_BYTES, stream, a);
}
```

```cpp
#include <hip/hip_runtime.h>
#include <hip/hip_bf16.h>
#include <cstdio>
#include <cstdint>
#include <cmath>

#define LAS __attribute__((address_space(3)))
#define GAS __attribute__((address_space(1)))
typedef unsigned short bf16_t;
typedef short bf16x8 __attribute__((ext_vector_type(8)));
typedef short s16x4 __attribute__((ext_vector_type(4)));
typedef float f32x4 __attribute__((ext_vector_type(4)));
typedef float f32x2 __attribute__((ext_vector_type(2)));
typedef float f32x16 __attribute__((ext_vector_type(16)));
typedef float f32x8 __attribute__((ext_vector_type(8)));
typedef unsigned u32x4 __attribute__((ext_vector_type(4)));
typedef unsigned u32x2 __attribute__((ext_vector_type(2)));

constexpr int D = 2048, BATCH = 4, SEQ = 8192, M = BATCH * SEQ, DEPTH = 2, NMEM = 256, DFF = 5632;
constexpr int NIN = 6680, NPROJ = 6912;
constexpr int PJW = 256;
__device__ __forceinline__ int ktm(int col) { return (col >> 6) * (M * 64) + (col & 63); }
__device__ __forceinline__ size_t pjcol(int col) { return (size_t)(col >> 8) * ((size_t)M * PJW) + (size_t)(col & 255); }
constexpr float LN_EPS = 1e-5f;
constexpr float ALPHA = 1.41421356237309515f;
constexpr float LOG2E = 1.4426950408889634f;
constexpr int PQ_A = 0, PK_A = 256, PV_A = 512, PR_A = 1024, PQ_B = 1536, PF_B = 2048, PI_B = 2560, PG_B = 3072,
              PQ_C = 3584, PK_C = 4096, PV_C = 4608, PQ_D = 5120, PK_D = 5376, PV_D = 5632, PO_D = 6144, P_SMALL = 6656;

__device__ __forceinline__ int lane_id() { int l; asm volatile("v_mbcnt_lo_u32_b32 %0, -1, 0\n\tv_mbcnt_hi_u32_b32 %0, -1, %0" : "=v"(l)); return l; }
__device__ __forceinline__ float xsum16_32(float x) { auto r = __builtin_amdgcn_permlane16_swap(__float_as_uint(x), __float_as_uint(x), false, false); x = __uint_as_float(r[0]) + __uint_as_float(r[1]);
    auto r2 = __builtin_amdgcn_permlane32_swap(__float_as_uint(x), __float_as_uint(x), false, false); return __uint_as_float(r2[0]) + __uint_as_float(r2[1]); }
__device__ __forceinline__ float xmax16_32(float x) { auto r = __builtin_amdgcn_permlane16_swap(__float_as_uint(x), __float_as_uint(x), false, false); x = fmaxf(__uint_as_float(r[0]), __uint_as_float(r[1]));
    auto r2 = __builtin_amdgcn_permlane32_swap(__float_as_uint(x), __float_as_uint(x), false, false); return fmaxf(__uint_as_float(r2[0]), __uint_as_float(r2[1])); }
__device__ __forceinline__ float shx(float v, int m, int lane) { return __int_as_float(__builtin_amdgcn_ds_bpermute((lane ^ m) << 2, __float_as_int(v))); }
typedef __bf16 bf16x2_t __attribute__((ext_vector_type(2)));
__device__ __forceinline__ unsigned cvt_pk_bf16(float lo, float hi) { unsigned r; asm volatile("v_cvt_pk_bf16_f32 %0, %1, %2" : "=v"(r) : "v"(lo), "v"(hi)); return r; }
__device__ __forceinline__ unsigned cvt_pk_bf16_c(float lo, float hi) { f32x2 v = {lo, hi}; bf16x2_t b = __builtin_convertvector(v, bf16x2_t); return __builtin_bit_cast(unsigned, b); }
__device__ __forceinline__ float bf2f(unsigned short b) { return __uint_as_float(((unsigned)b) << 16); }
__device__ __forceinline__ float bflo(unsigned w) { return __uint_as_float(w << 16); }
__device__ __forceinline__ float bfhi(unsigned w) { return __uint_as_float(w & 0xffff0000u); }
__device__ __forceinline__ unsigned short f2bf(float f) { return (unsigned short)(cvt_pk_bf16_c(f, 0.f) & 0xffffu); }
__device__ __forceinline__ float fast_exp2(float x) { return __builtin_amdgcn_exp2f(x); }
__device__ __forceinline__ float fast_exp(float x) { return __builtin_amdgcn_exp2f(x * LOG2E); }
__device__ __forceinline__ float fast_rcp(float x) { return __builtin_amdgcn_rcpf(x); }
__device__ __forceinline__ float sigmoidf_(float x) { return fast_rcp(1.f + fast_exp(-x)); }
__device__ __forceinline__ float siluf_(float x) { return x * sigmoidf_(x); }
__device__ __forceinline__ float logsigmoidf_(float x) { return fminf(x, 0.f) - log1pf(__expf(-fabsf(x))); }

namespace pg8 {
constexpr int BM = 256, BK = 64, HALF = 128, HTB = HALF * BK * 2, STAGE_BYTES = 8 * HTB, NXCD = 8, WGM = 8;
__host__ __device__ __forceinline__ int lds_byte(int r, int c) { const int st = (r >> 4) * 2 + (c >> 5), rr = r & 15, cc = c & 31, ob = rr * 64 + cc * 2; return st * 1024 + (ob ^ (((ob >> 9) & 1) << 5)); }
__host__ __device__ __forceinline__ void stage_rc(int b, int& R, int& C) { const int st = b / 1024, sb = b % 1024, swz = sb ^ (((sb >> 9) & 1) << 5); R = (st >> 1) * 16 + swz / 64; C = (st & 1) * 32 + (swz % 64) / 2; }
__host__ __device__ __forceinline__ int perm32(int rho) { const int n = rho >> 4, i = rho & 15; return 8 * (i >> 2) + 4 * n + (i & 3); }

struct Unit { int pm, pn; unsigned aoff, boff, coff; };
struct Gemm { const bf16_t* A; const bf16_t* Bt; };

struct StaticOrder {
    int nM, nN, nwg, G, c, lda, ldb, ldc, cw;
    __device__ void init(int Mr, int Nc, int G_, int c_, int lda_, int ldb_, int ldc_, int cw_) { nM = Mr / BM; nN = Nc / BM; nwg = nM * nN; G = G_; c = c_; lda = lda_; ldb = ldb_; ldc = ldc_; cw = cw_; }
    __device__ bool next(int i, Unit& u) const {
        const long L = (long)i * G + c; if (L >= nwg || c < 0) return false;
        int wgid = (int)L; { const int q = nwg / NXCD, r = nwg % NXCD, xcd = wgid % NXCD, off = wgid / NXCD; wgid = (xcd < r ? xcd * (q + 1) : r * (q + 1) + (xcd - r) * q) + off; }
        const int nig = WGM * nN, gid = wgid / nig, fm = gid * WGM, gsz = (nM - fm) < WGM ? (nM - fm) : WGM;
        u.pm = fm + ((wgid % nig) % gsz); u.pn = (wgid % nig) / gsz;
        u.aoff = (unsigned)(u.pm * BM) * (unsigned)lda; u.boff = (unsigned)(u.pn * BM) * (unsigned)ldb; u.coff = (unsigned)(u.pm * BM) * (unsigned)ldc + (unsigned)(u.pn * cw); return true;
    }
};

template <int LDA, int LDB, int KK, class Epi, class Sched, int AKS = 0, int BKS = 0>
__device__ __forceinline__ void gemm_phase(LAS unsigned char* lds, int wave, const Gemm g, const Sched& S, const Epi& E) {
    int tid_ = wave * 64 + lane_id();
    int wid_ = wave; asm volatile("" : "+s"(wid_));
    const int tid = tid_, wid = wid_, lane = tid & 63, wr = wid >> 2, wc = wid & 3, fr = lane & 15, fq = lane >> 4;
    constexpr int nt = KK / BK;
    unsigned voffA[2], voffB[2];
#pragma unroll
    for (int i = 0; i < 2; ++i) { int R, C; stage_rc(tid * 16 + i * 8192, R, C); const int Rb = Epi::PERM ? ((R & ~31) + perm32(R & 31)) : R;
        voffA[i] = (unsigned)(R * LDA + C) * 2u; voffB[i] = (unsigned)(Rb * LDB + C) * 2u; }
    constexpr size_t kstep = (size_t)(BK * 2), kstepA = AKS ? (size_t)AKS * 2 : kstep, kstepB = BKS ? (size_t)BKS * 2 : kstep;
    constexpr size_t hstepA = (size_t)HALF * LDA * 2, hstepB = (size_t)HALF * LDB * 2;
    const unsigned ldsw = (unsigned)wid * 1024u;
    const int aoff = lds_byte(wr * 64 + fr, fq * 8), boff = lds_byte(wc * 32 + fr, fq * 8);
#define PG8_SA(b, h) (((b) * 2 + (h)) * HTB)
#define PG8_SB(b, h) ((4 + (b) * 2 + (h)) * HTB)
#define PG8_STAGE(bufoff, gbase, voff) do { _Pragma("unroll") for (int _i = 0; _i < 2; ++_i) \
        __builtin_amdgcn_global_load_lds((const unsigned*)((const char*)(gbase) + (voff)[_i]), (LAS unsigned*)(lds + (bufoff) + ldsw + _i * 8192), 16, 0, 0); } while (0)
#define PG8_LDA(dst, b, h) do { _Pragma("unroll") for (int m = 0; m < 4; ++m) _Pragma("unroll") for (int k = 0; k < 2; ++k) dst[m][k] = *(const LAS bf16x8*)(lds + PG8_SA(b, h) + aoff + m * 2048 + k * 1024); } while (0)
#define PG8_LDB(dst, b, h) do { _Pragma("unroll") for (int n = 0; n < 2; ++n) _Pragma("unroll") for (int k = 0; k < 2; ++k) dst[n][k] = *(const LAS bf16x8*)(lds + PG8_SB(b, h) + boff + n * 2048 + k * 1024); } while (0)
#define PG8_MMA(ai, bj, At, Bt) do { __builtin_amdgcn_s_setprio(1); _Pragma("unroll") for (int m = 0; m < 4; ++m) _Pragma("unroll") for (int n = 0; n < 2; ++n) _Pragma("unroll") for (int k = 0; k < 2; ++k) \
        acc[ai][bj][m][n] = __builtin_amdgcn_mfma_f32_16x16x32_bf16(Bt[n][k], At[m][k], acc[ai][bj][m][n], 0, 0, 0); __builtin_amdgcn_s_setprio(0); } while (0)
#define PG8_WAIT_V(n) asm volatile("s_waitcnt vmcnt(" #n ")" ::: "memory")
#define PG8_WAIT_L(n) asm volatile("s_waitcnt lgkmcnt(" #n ")" ::: "memory")
#define PG8_BAR __builtin_amdgcn_s_barrier()
#define PG8_SCHED __builtin_amdgcn_sched_barrier(0)
    Unit cur, nxt; int ui = 0;
    if (!S.next(0, cur)) return;
    f32x4 acc[2][2][4][2];
#pragma unroll
    for (int a = 0; a < 2; ++a)
#pragma unroll
        for (int b = 0; b < 2; ++b)
#pragma unroll
            for (int m = 0; m < 4; ++m)
#pragma unroll
                for (int n = 0; n < 2; ++n) acc[a][b][m][n] = (f32x4){0.f, 0.f, 0.f, 0.f};
    bf16x8 At[4][2], B0[2][2], B1[2][2];
    const char* cA = (const char*)(g.A + cur.aoff); const char* cB = (const char*)(g.Bt + cur.boff);
    PG8_STAGE(PG8_SB(0, 0), cB, voffB); PG8_STAGE(PG8_SB(0, 1), cB + hstepB, voffB); PG8_STAGE(PG8_SA(0, 0), cA, voffA); PG8_STAGE(PG8_SA(0, 1), cA + hstepA, voffA);
    if (wr == 1) PG8_BAR;
    PG8_WAIT_V(2); PG8_BAR;
    PG8_STAGE(PG8_SB(1, 0), cB + kstepB, voffB); PG8_STAGE(PG8_SA(1, 0), cA + kstepA, voffA); PG8_STAGE(PG8_SB(1, 1), cB + hstepB + kstepB, voffB);
    PG8_WAIT_V(6); PG8_BAR;
    for (;;) {
        const bool has_next = S.next(ui + 1, nxt);
        const char* nA = has_next ? (const char*)(g.A + nxt.aoff) : cA; const char* nB = has_next ? (const char*)(g.Bt + nxt.boff) : cB;
        for (int t = 0; t < nt; t += 2) {
            const bool last = (t == nt - 2);
            const char* a1 = cA + (size_t)(t + 1) * kstepA;
            const char* a2 = last ? nA : cA + (size_t)(t + 2) * kstepA; const char* b2 = last ? nB : cB + (size_t)(t + 2) * kstepB;
            const char* a3 = a2 + kstepA; const char* b3 = b2 + kstepB;
            PG8_LDB(B0, 0, 0); PG8_LDB(B1, 0, 1); PG8_SCHED; PG8_LDA(At, 0, 0); PG8_STAGE(PG8_SA(1, 1), a1 + hstepA, voffA);
            PG8_WAIT_V(8); PG8_WAIT_L(0); PG8_BAR; PG8_MMA(0, 0, At, B0); PG8_MMA(0, 1, At, B1); PG8_BAR; PG8_SCHED;
            PG8_LDA(At, 0, 1); PG8_STAGE(PG8_SB(0, 0), b2, voffB); PG8_STAGE(PG8_SB(0, 1), b2 + hstepB, voffB); PG8_STAGE(PG8_SA(0, 0), a2, voffA);
            PG8_WAIT_V(8); PG8_WAIT_L(0); PG8_BAR; PG8_MMA(1, 0, At, B0); PG8_MMA(1, 1, At, B1); PG8_BAR; PG8_SCHED;
            PG8_LDB(B0, 1, 0); PG8_LDB(B1, 1, 1); PG8_SCHED; PG8_LDA(At, 1, 0); PG8_STAGE(PG8_SA(0, 1), a2 + hstepA, voffA);
            PG8_WAIT_V(8); PG8_WAIT_L(0); PG8_BAR; PG8_MMA(0, 0, At, B0); PG8_MMA(0, 1, At, B1); PG8_BAR; PG8_SCHED;
            PG8_LDA(At, 1, 1); PG8_STAGE(PG8_SB(1, 0), b3, voffB); PG8_STAGE(PG8_SB(1, 1), b3 + hstepB, voffB); PG8_STAGE(PG8_SA(1, 0), a3, voffA);
            PG8_WAIT_V(8); PG8_WAIT_L(0); PG8_BAR; PG8_MMA(1, 0, At, B0); PG8_MMA(1, 1, At, B1); PG8_BAR; PG8_SCHED;
        }
        if (wr == 0) PG8_BAR;
        if constexpr (!Epi::AFTER_DRAIN) { int fr_e = fr, fq_e = fq, wr_e = wr, wc_e = wc; asm volatile("" : "+v"(fr_e), "+v"(fq_e), "+s"(wr_e), "+s"(wc_e));
          E(acc, cur, wr_e, wc_e, fr_e, fq_e, lds); }
        if (!has_next) break;
#pragma unroll
        for (int a = 0; a < 2; ++a)
#pragma unroll
            for (int b = 0; b < 2; ++b)
#pragma unroll
                for (int m = 0; m < 4; ++m)
#pragma unroll
                    for (int n = 0; n < 2; ++n) acc[a][b][m][n] = (f32x4){0.f, 0.f, 0.f, 0.f};
        cur = nxt; cA = nA; cB = nB; ++ui;
        if (wr == 1) PG8_BAR;
    }
    PG8_WAIT_V(0);
    PG8_BAR;
    if constexpr (Epi::AFTER_DRAIN) {
        int fr_e = fr, fq_e = fq, wr_e = wr, wc_e = wc, wid_e = wid; asm volatile("" : "+v"(fr_e), "+v"(fq_e), "+s"(wr_e), "+s"(wc_e), "+s"(wid_e));
        E.fused(acc, cur, wr_e, wc_e, fr_e, fq_e, lds, wid_e);
    }
#undef PG8_SA
#undef PG8_SB
#undef PG8_STAGE
#undef PG8_LDA
#undef PG8_LDB
#undef PG8_MMA
#undef PG8_WAIT_V
#undef PG8_WAIT_L
#undef PG8_SCHED
}

constexpr int EPI_LDS_OFF = 135168;

struct EpiSwiGLUkt {
    static constexpr bool AFTER_DRAIN = false, PERM = true;
    bf16_t* H;
    __device__ __forceinline__ void operator()(const f32x4 (&acc)[2][2][4][2], const Unit& u, int wr, int wc, int fr, int fq, LAS unsigned char*) const {
        bf16_t* base = H + (size_t)(2 * u.pn + (wc >> 1)) * ((size_t)M * 64) + (size_t)(u.pm * BM + wr * 64 + fr) * 64 + (wc & 1) * 32 + 8 * fq;
#pragma unroll
        for (int ai = 0; ai < 2; ++ai)
#pragma unroll
            for (int m = 0; m < 4; ++m) {
                const f32x4 g0 = acc[ai][0][m][0], g1 = acc[ai][0][m][1], u0 = acc[ai][1][m][0], u1 = acc[ai][1][m][1];
                f32x4 e0 = g0 * (-LOG2E), e1 = g1 * (-LOG2E);
#pragma unroll
                for (int i = 0; i < 4; ++i) { e0[i] = fast_exp2(e0[i]); e1[i] = fast_exp2(e1[i]); }
                e0 = e0 + 1.0f; e1 = e1 + 1.0f;
#pragma unroll
                for (int i = 0; i < 4; ++i) { e0[i] = fast_rcp(e0[i]); e1[i] = fast_rcp(e1[i]); }
                const f32x4 h0 = (g0 * u0) * e0, h1 = (g1 * u1) * e1;
                u32x4 w; w.x = cvt_pk_bf16(h0[0], h0[1]); w.y = cvt_pk_bf16(h0[2], h0[3]); w.z = cvt_pk_bf16(h1[0], h1[1]); w.w = cvt_pk_bf16(h1[2], h1[3]);
                *(u32x4*)(base + (size_t)(ai * HALF + m * 16) * 64) = w;
            }
    }
};
struct EpiSwiGLU {
    static constexpr bool AFTER_DRAIN = false, PERM = true;
    bf16_t* H; int ldh;
    __device__ __forceinline__ void operator()(const f32x4 (&acc)[2][2][4][2], const Unit& u, int wr, int wc, int fr, int fq, LAS unsigned char*) const {
        bf16_t* base = H + u.coff + (size_t)(wr * 64 + fr) * ldh + wc * 32 + 8 * fq;
#pragma unroll
        for (int ai = 0; ai < 2; ++ai)
#pragma unroll
            for (int m = 0; m < 4; ++m) {
                const f32x4 g0 = acc[ai][0][m][0], g1 = acc[ai][0][m][1], u0 = acc[ai][1][m][0], u1 = acc[ai][1][m][1];
                f32x4 e0 = g0 * (-LOG2E), e1 = g1 * (-LOG2E);
#pragma unroll
                for (int i = 0; i < 4; ++i) { e0[i] = fast_exp2(e0[i]); e1[i] = fast_exp2(e1[i]); }
                e0 = e0 + 1.0f; e1 = e1 + 1.0f;
#pragma unroll
                for (int i = 0; i < 4; ++i) { e0[i] = fast_rcp(e0[i]); e1[i] = fast_rcp(e1[i]); }
                const f32x4 h0 = (g0 * u0) * e0, h1 = (g1 * u1) * e1;
                u32x4 w; w.x = cvt_pk_bf16(h0[0], h0[1]); w.y = cvt_pk_bf16(h0[2], h0[3]); w.z = cvt_pk_bf16(h1[0], h1[1]); w.w = cvt_pk_bf16(h1[2], h1[3]);
                *(u32x4*)(base + (size_t)(ai * HALF + m * 16) * ldh) = w;
            }
    }
};
struct EpiRes {
    static constexpr bool AFTER_DRAIN = false, PERM = false;
    const float* X; float* Y; float s;
    __device__ __forceinline__ void operator()(const f32x4 (&acc)[2][2][4][2], const Unit& u, int wr, int wc, int fr, int fq, LAS unsigned char*) const {
        const size_t o0 = u.coff + (size_t)(wr * 64 + fr) * D + wc * 32 + 4 * fq;
#pragma unroll
        for (int ai = 0; ai < 2; ++ai)
#pragma unroll
            for (int m = 0; m < 4; ++m) { const size_t off = o0 + (size_t)(ai * HALF + m * 16) * D;
#pragma unroll
                for (int bj = 0; bj < 2; ++bj)
#pragma unroll
                    for (int n = 0; n < 2; ++n) { const f32x4 x = *(const f32x4*)(X + off + bj * HALF + n * 16); *(f32x4*)(Y + off + bj * HALF + n * 16) = x * ALPHA + acc[ai][bj][m][n] * s; } }
    }
};
struct EpiBf16 {
    static constexpr bool AFTER_DRAIN = false, PERM = true;
    bf16_t* O; int ldc; float scale; float* G; int gate_tile;
    __device__ __forceinline__ void operator()(const f32x4 (&acc)[2][2][4][2], const Unit& u, int wr, int wc, int fr, int fq, LAS unsigned char*) const {
        bf16_t* base = O + u.coff + (size_t)(wr * 64 + fr) * ldc + wc * 32 + 8 * fq;
#pragma unroll
        for (int ai = 0; ai < 2; ++ai)
#pragma unroll
            for (int m = 0; m < 4; ++m) { bf16_t* rowp = base + (size_t)(ai * HALF + m * 16) * ldc;
#pragma unroll
                for (int bj = 0; bj < 2; ++bj) { const f32x4 v0 = acc[ai][bj][m][0] * scale, v1 = acc[ai][bj][m][1] * scale;
                    u32x4 w; w.x = cvt_pk_bf16(v0[0], v0[1]); w.y = cvt_pk_bf16(v0[2], v0[3]); w.z = cvt_pk_bf16(v1[0], v1[1]); w.w = cvt_pk_bf16(v1[2], v1[3]);
                    *(u32x4*)(rowp + bj * HALF) = w; } }
        if (G != nullptr && u.pn == gate_tile && wc == 0) {
#pragma unroll
            for (int ai = 0; ai < 2; ++ai)
#pragma unroll
                for (int m = 0; m < 4; ++m) { float* gp = G + (size_t)(u.pm * BM + ai * HALF + wr * 64 + m * 16 + fr) * 32 + 8 * fq;
                    *(f32x4*)(gp) = acc[ai][0][m][0]; *(f32x4*)(gp + 4) = acc[ai][0][m][1]; }
        }
    }
};
struct EpiSoftmax {
    static constexpr bool AFTER_DRAIN = false, PERM = true;
    bf16_t* P; int ldc;
    __device__ __forceinline__ void operator()(f32x4 (&acc)[2][2][4][2], const Unit& u, int wr, int wc, int fr, int fq, LAS unsigned char* lds) const {
        LAS float* smax = (LAS float*)(lds + EPI_LDS_OFF); LAS float* ssum = smax + 1024;
#pragma unroll
        for (int ai = 0; ai < 2; ++ai)
#pragma unroll
            for (int m = 0; m < 4; ++m) { float mx = -3.0e38f;
#pragma unroll
                for (int bj = 0; bj < 2; ++bj)
#pragma unroll
                    for (int n = 0; n < 2; ++n) { const f32x4 x = acc[ai][bj][m][n]; mx = fmaxf(mx, fmaxf(fmaxf(x[0], x[1]), fmaxf(x[2], x[3]))); }
                mx = xmax16_32(mx);
                if (fq == 0) smax[wc * 256 + ai * HALF + wr * 64 + m * 16 + fr] = mx; }
        asm volatile("s_waitcnt lgkmcnt(0)" ::: "memory"); PG8_BAR; asm volatile("" ::: "memory");
#pragma unroll
        for (int ai = 0; ai < 2; ++ai)
#pragma unroll
            for (int m = 0; m < 4; ++m) { const int r = ai * HALF + wr * 64 + m * 16 + fr;
                const float mx = fmaxf(fmaxf(smax[r], smax[256 + r]), fmaxf(smax[512 + r], smax[768 + r])); float s = 0.f;
#pragma unroll
                for (int bj = 0; bj < 2; ++bj)
#pragma unroll
                    for (int n = 0; n < 2; ++n) { f32x4 x = acc[ai][bj][m][n];
                        x[0] = fast_exp2(x[0] - mx); x[1] = fast_exp2(x[1] - mx); x[2] = fast_exp2(x[2] - mx); x[3] = fast_exp2(x[3] - mx);
                        s += (x[0] + x[1]) + (x[2] + x[3]); acc[ai][bj][m][n] = x; }
                s = xsum16_32(s);
                if (fq == 0) ssum[wc * 256 + r] = s; }
        asm volatile("s_waitcnt lgkmcnt(0)" ::: "memory"); PG8_BAR; asm volatile("" ::: "memory");
        bf16_t* base = P + (size_t)(4 * u.pn + (wc >> 1)) * ((size_t)M * 64) + (size_t)(u.pm * BM + wr * 64 + fr) * 64 + (wc & 1) * 32 + 8 * fq;
#pragma unroll
        for (int ai = 0; ai < 2; ++ai)
#pragma unroll
            for (int m = 0; m < 4; ++m) { const int r = ai * HALF + wr * 64 + m * 16 + fr;
                const float inv = 1.0f / ((ssum[r] + ssum[256 + r]) + (ssum[512 + r] + ssum[768 + r]));
                bf16_t* rowp = base + (size_t)(ai * HALF + m * 16) * 64;
#pragma unroll
                for (int bj = 0; bj < 2; ++bj) { const f32x4 v0 = acc[ai][bj][m][0] * inv, v1 = acc[ai][bj][m][1] * inv;
                    u32x4 w; w.x = cvt_pk_bf16(v0[0], v0[1]); w.y = cvt_pk_bf16(v0[2], v0[3]); w.z = cvt_pk_bf16(v1[0], v1[1]); w.w = cvt_pk_bf16(v1[2], v1[3]);
                    *(u32x4*)(rowp + (size_t)bj * (2 * (size_t)M * 64)) = w; } }
    }
};

struct PanelStats8 {
    unsigned long long* xbuf;
    unsigned* cnt;
    unsigned* tmo;
    __device__ __forceinline__ bool run(const f32x4 (&v)[2][2][4][2], int panel, int pn, int wr, int wc, int fr, int fq, LAS unsigned char* lds, int wid) const {
        LAS f32x2* P = (LAS f32x2*)lds;
        LAS f32x2* S = (LAS f32x2*)(lds + 8192);
        LAS unsigned* flag = (LAS unsigned*)(lds + 8192 + 2048);
        const int lane = fr + 16 * fq;
#pragma unroll
        for (int ai = 0; ai < 2; ++ai)
#pragma unroll
            for (int m = 0; m < 4; ++m) {
                const f32x4 sv = (v[ai][0][m][0] + v[ai][0][m][1]) + (v[ai][1][m][0] + v[ai][1][m][1]);
                const float s = xsum16_32((sv[0] + sv[1]) + (sv[2] + sv[3]));
                const float mw = s * (1.0f / 64.0f);
                const f32x4 d0 = v[ai][0][m][0] - mw, d1 = v[ai][0][m][1] - mw, d2 = v[ai][1][m][0] - mw, d3 = v[ai][1][m][1] - mw;
                const f32x4 qv = (d0 * d0 + d1 * d1) + (d2 * d2 + d3 * d3);
                const float q = xsum16_32((qv[0] + qv[1]) + (qv[2] + qv[3]));
                if (fq == 0) P[(ai * HALF + wr * 64 + m * 16 + fr) * 4 + wc] = (f32x2){mw, q};
            }
        asm volatile("s_waitcnt lgkmcnt(0)" ::: "memory"); PG8_BAR; asm volatile("" ::: "memory");
        const int row = wid * 32 + (lane & 31);
        if (lane < 32) {
            const f32x2 a = P[row * 4 + 0], b = P[row * 4 + 1], c = P[row * 4 + 2], d = P[row * 4 + 3];
            const float mt = (a.x + b.x + c.x + d.x) * 0.25f;
            const float da = a.x - mt, db = b.x - mt, dc = c.x - mt, dd = d.x - mt;
            const float m2 = (a.y + b.y) + (c.y + d.y) + 64.0f * ((da * da + db * db) + (dc * dc + dd * dd));
            __hip_atomic_store(xbuf + ((size_t)(panel * BM + row) * 8 + pn), ((unsigned long long)__float_as_uint(m2) << 32) | __float_as_uint(mt), __ATOMIC_RELAXED, __HIP_MEMORY_SCOPE_AGENT);
        }
        asm volatile("s_waitcnt vmcnt(0)" ::: "memory"); PG8_BAR; asm volatile("" ::: "memory");
        if (wid == 0) {
            if (lane == 0) __hip_atomic_fetch_add(cnt + 64 * panel, 1u, __ATOMIC_RELAXED, __HIP_MEMORY_SCOPE_AGENT);
            bool dead = false; unsigned sp = 0u;
            for (;;) {
                if ((unsigned)__builtin_amdgcn_readfirstlane(__hip_atomic_load(cnt + 64 * panel, __ATOMIC_RELAXED, __HIP_MEMORY_SCOPE_AGENT)) >= 8u) break;
                if (++sp > (1u << 20)) { if (lane == 0) __hip_atomic_store(tmo, 1u, __ATOMIC_RELAXED, __HIP_MEMORY_SCOPE_AGENT); dead = true; break; }
                __builtin_amdgcn_s_sleep(1);
            }
            __builtin_amdgcn_fence(__ATOMIC_ACQUIRE, "agent");
            if (lane == 0) flag[0] = dead ? 1u : 0u;
        }
        asm volatile("s_waitcnt vmcnt(0) lgkmcnt(0)" ::: "memory"); PG8_BAR; asm volatile("" ::: "memory");
        const bool bad = flag[0] != 0u;
        if (lane < 32) {
            const unsigned long long* slot = xbuf + (size_t)(panel * BM + row) * 8; float mt[8], m2[8]; float ms = 0.f;
#pragma unroll
            for (int t = 0; t < 8; ++t) { const unsigned long long w = __hip_atomic_load(slot + t, __ATOMIC_RELAXED, __HIP_MEMORY_SCOPE_AGENT); mt[t] = __uint_as_float((unsigned)w); m2[t] = __uint_as_float((unsigned)(w >> 32)); ms += mt[t]; }
            const float mean = ms * 0.125f; float q = 0.f;
#pragma unroll
            for (int t = 0; t < 8; ++t) { const float dm = mt[t] - mean; q += m2[t] + 256.0f * dm * dm; }
            S[row] = (f32x2){mean, 1.0f / sqrtf(q * (1.0f / 2048.0f) + LN_EPS)};
        }
        asm volatile("s_waitcnt lgkmcnt(0)" ::: "memory"); PG8_BAR; asm volatile("" ::: "memory");
        return bad;
    }
};
template <bool XIN_F32, bool OUT_F32, bool DRAIN = true>
struct EpiLnRes {
    static constexpr bool AFTER_DRAIN = DRAIN, PERM = true;
    __device__ __forceinline__ void operator()(f32x4 (&acc)[2][2][4][2], const Unit& u, int wr, int wc, int fr, int fq, LAS unsigned char* lds) const { fused(acc, u, wr, wc, fr, fq, lds + EPI_LDS_OFF, wr * 4 + wc); }
    const float* X; float* Y; const bf16_t* XB; bf16_t* XBO; const float* g; const float* b; float s; PanelStats8 st;
    __device__ __forceinline__ void fused(f32x4 (&acc)[2][2][4][2], const Unit& u, int wr, int wc, int fr, int fq, LAS unsigned char* lds, int wid) const {
        const LAS f32x2* S = (const LAS f32x2*)(lds + 8192);
        { const size_t o0 = (size_t)u.coff + (size_t)(wr * 64 + fr) * D + wc * 32 + 8 * fq;
          const size_t k0 = (size_t)(4 * u.pn + (wc >> 1)) * ((size_t)M * 64) + (size_t)(u.pm * BM + wr * 64 + fr) * 64 + (wc & 1) * 32 + 8 * fq;
#pragma unroll
        for (int ai = 0; ai < 2; ++ai) {
            if (XIN_F32) {
                f32x4 xr[4][2][2];
#pragma unroll
                for (int m = 0; m < 4; ++m)
#pragma unroll
                    for (int bj = 0; bj < 2; ++bj) { const size_t off = o0 + (size_t)(ai * HALF + m * 16) * D + bj * HALF; xr[m][bj][0] = *(const f32x4*)(X + off); xr[m][bj][1] = *(const f32x4*)(X + off + 4); }
#pragma unroll
                for (int m = 0; m < 4; ++m) {
#pragma unroll
                    for (int bj = 0; bj < 2; ++bj) { acc[ai][bj][m][0] = xr[m][bj][0] * ALPHA + acc[ai][bj][m][0] * s; acc[ai][bj][m][1] = xr[m][bj][1] * ALPHA + acc[ai][bj][m][1] * s; }
                    asm volatile("" : "+v"(acc[ai][0][m][0]), "+v"(acc[ai][0][m][1]), "+v"(acc[ai][1][m][0]), "+v"(acc[ai][1][m][1])); }
            } else {
                u32x4 xr[4][2];
#pragma unroll
                for (int m = 0; m < 4; ++m)
#pragma unroll
                    for (int bj = 0; bj < 2; ++bj) xr[m][bj] = *(const u32x4*)(XB + k0 + (size_t)(ai * HALF + m * 16) * 64 + (size_t)bj * (2 * (size_t)M * 64));
#pragma unroll
                for (int m = 0; m < 4; ++m) {
#pragma unroll
                    for (int bj = 0; bj < 2; ++bj) { const u32x4 w = xr[m][bj]; const f32x4 x0 = (f32x4){bflo(w.x), bfhi(w.x), bflo(w.y), bfhi(w.y)}, x1 = (f32x4){bflo(w.z), bfhi(w.z), bflo(w.w), bfhi(w.w)};
                        acc[ai][bj][m][0] = x0 * ALPHA + acc[ai][bj][m][0] * s; acc[ai][bj][m][1] = x1 * ALPHA + acc[ai][bj][m][1] * s; }
                    asm volatile("" : "+v"(acc[ai][0][m][0]), "+v"(acc[ai][0][m][1]), "+v"(acc[ai][1][m][0]), "+v"(acc[ai][1][m][1])); }
            }
            asm volatile("" ::: "memory"); } }
        f32x4 gq[2][2], bq[2][2];
        { const int c0 = u.pn * BM + wc * 32 + 8 * fq;
#pragma unroll
            for (int bj = 0; bj < 2; ++bj) { gq[bj][0] = *(const f32x4*)(g + c0 + bj * HALF); gq[bj][1] = *(const f32x4*)(g + c0 + bj * HALF + 4); bq[bj][0] = *(const f32x4*)(b + c0 + bj * HALF); bq[bj][1] = *(const f32x4*)(b + c0 + bj * HALF + 4); } }
        const bool bad = st.run(acc, u.pm, u.pn, wr, wc, fr, fq, lds, wid);
        const float qnan = __builtin_nanf("");
        { int fr2 = fr, fq2 = fq; asm volatile("" : "+v"(fr2), "+v"(fq2)); fr = fr2; fq = fq2; }
        const size_t o0 = (size_t)u.coff + (size_t)(wr * 64 + fr) * D + wc * 32 + 8 * fq;
        const size_t k0 = (size_t)(4 * u.pn + (wc >> 1)) * ((size_t)M * 64) + (size_t)(u.pm * BM + wr * 64 + fr) * 64 + (wc & 1) * 32 + 8 * fq;
#pragma unroll
        for (int bj = 0; bj < 2; ++bj) { const f32x4 g0 = gq[bj][0], g1 = gq[bj][1], b0 = bq[bj][0], b1 = bq[bj][1];
#pragma unroll
            for (int ai = 0; ai < 2; ++ai)
#pragma unroll
                for (int m = 0; m < 4; ++m) { const int r = ai * HALF + wr * 64 + m * 16 + fr; const f32x2 sr = S[r]; const size_t off = o0 + (size_t)(ai * HALF + m * 16) * D + bj * HALF;
                    f32x4 o0v = (acc[ai][bj][m][0] - sr.x) * sr.y * g0 + b0, o1v = (acc[ai][bj][m][1] - sr.x) * sr.y * g1 + b1;
                    if (bad) { o0v = (f32x4){qnan, qnan, qnan, qnan}; o1v = o0v; }
                    if (OUT_F32) { *(f32x4*)(Y + off) = o0v; *(f32x4*)(Y + off + 4) = o1v; }
                    else { u32x4 w; w.x = cvt_pk_bf16(o0v[0], o0v[1]); w.y = cvt_pk_bf16(o0v[2], o0v[3]); w.z = cvt_pk_bf16(o1v[0], o1v[1]); w.w = cvt_pk_bf16(o1v[2], o1v[3]); *(u32x4*)(XBO + k0 + (size_t)(ai * HALF + m * 16) * 64 + (size_t)bj * (2 * (size_t)M * 64)) = w; } } }
    }
};
struct PanelOrder4 { int c, lda, ldb; unsigned bbatch; int rev;
    __device__ bool next(int i, Unit& u) const { if (i >= 4) return false; const int x = c & 7, j = c >> 3; u.pm = rev ? 16 * x + 8 * (i < 2 ? 1 : 0) + 4 * (i & 1) + (j >> 3) : i * 32 + 4 * x + (j >> 3); u.pn = j & 7;
        u.aoff = (unsigned)(u.pm * BM) * (unsigned)lda; u.boff = (unsigned)(u.pn * BM) * (unsigned)ldb + (unsigned)(u.pm >> 5) * bbatch; u.coff = (unsigned)(u.pm * BM) * (unsigned)D + (unsigned)(u.pn * BM); return true; } };
struct PanelOrder { int round, c, lda, ldb;
    __device__ bool next(int i, Unit& u) const { if (i != 0) return false; const int x = c & 7, j = c >> 3; u.pm = round * 32 + 4 * x + (j >> 3); u.pn = j & 7;
        u.aoff = (unsigned)(u.pm * BM) * (unsigned)lda; u.boff = (unsigned)(u.pn * BM) * (unsigned)ldb; u.coff = (unsigned)(u.pm * BM) * (unsigned)D + (unsigned)(u.pn * BM); return true; } };
#undef PG8_BAR
}

constexpr size_t MiB = 1u << 20;
constexpr size_t SZ_WFI = (size_t)2 * DFF * D * 2, SZ_WFO = (size_t)D * DFF * 2, SZ_WMI = (size_t)NPROJ * D * 2, SZ_WDD = (size_t)D * D * 2, SZ_WKV = (size_t)2 * D * D * 2;
constexpr size_t WS_CTL = 0, CTL_ZERO_BYTES = 384 * 1024;
constexpr size_t WS_WFI = 2 * MiB;
constexpr size_t WS_WFO = WS_WFI + 4 * SZ_WFI;
constexpr size_t WS_WMI = WS_WFO + 4 * SZ_WFO;
constexpr size_t WS_WMO = WS_WMI + 2 * SZ_WMI;
constexpr size_t WS_WXQ = WS_WMO + 2 * SZ_WDD;
constexpr size_t WS_WXKV = WS_WXQ + 2 * SZ_WDD;
constexpr size_t WS_WXO = WS_WXKV + 2 * SZ_WKV;
constexpr size_t WS_XB = WS_WXO + 2 * SZ_WDD;
constexpr size_t WS_MEMB = WS_XB + (size_t)M * D * 2;
constexpr size_t WS_KB = WS_MEMB + (size_t)BATCH * NMEM * D * 2;
constexpr size_t WS_VT = WS_KB + (size_t)DEPTH * BATCH * NMEM * D * 2;
constexpr size_t WS_GATES = WS_VT + (size_t)DEPTH * BATCH * NMEM * D * 2;
constexpr size_t WS_MIXED = WS_GATES + (size_t)M * 32 * 4;
constexpr size_t WS_UNION = WS_MIXED + (size_t)M * D * 2;
constexpr size_t WS_XSLOT = WS_UNION + (size_t)M * NPROJ * 2;
constexpr size_t WS_PRE = WS_XSLOT + (size_t)M * 8 * 8;
constexpr size_t WS_PRE_HGRN = (size_t)2048 * (4 * 64 * 64 * 2 + 64 * 4);
constexpr size_t WS_PRE_ML = WS_PRE_HGRN + (size_t)2048 * (4 * 64 * 128 * 2 + 128 * 4);
constexpr size_t WS_END = WS_PRE + WS_PRE_ML + (size_t)2048 * (3 * 64 * 64 * 2 + 4 * 256);
constexpr size_t UN_WQK = 0, UN_VWO = (size_t)BATCH * 1024 * D * 2, UN_P = (size_t)M * D * 2;
static_assert(WS_END < (size_t)1400 * MiB, "workspace map");
constexpr int CW_TMO = 0, CW_BAR = 4096, CW_WQ = 16384, CW_SEAM = 32768, SEAM_BANK = 128 * 64;

constexpr int LDS_BYTES = 163840;
constexpr int RING_BYTES = 131072, LDSCTL_OFF = LDS_BYTES - 512, MISC_OFF = LDSCTL_OFF + 320;
constexpr int NWAVES = 8;

#define RLX_AGENT __ATOMIC_RELAXED, __HIP_MEMORY_SCOPE_AGENT
#define LDS_WAIT() asm volatile("s_waitcnt lgkmcnt(0)" ::: "memory")
#define VM_WAIT() asm volatile("s_waitcnt vmcnt(0)" ::: "memory")

#define XB_TMO      128
#define XB_XCNT(j)  (256  + 64 * (j))
#define XB_XSUB(j)  (1280 + 64 * (j))
#define XB_XGEN(j)  (2304 + 64 * (j))
#define XB_TOP      3328
#define XB_TOPGEN   3392
#define XB_LSUB(j)  (3584 + 64 * (j))
#define XB_XMAP     4736
#define XCD_BAR_WORDS 3456
#define XB_SPIN_CAP (1u << 20)
__device__ __forceinline__ unsigned xb_ld(unsigned* p)              { return __hip_atomic_load(p, __ATOMIC_RELAXED, __HIP_MEMORY_SCOPE_AGENT); }
__device__ __forceinline__ unsigned xb_add(unsigned* p, unsigned v) { return __hip_atomic_fetch_add(p, v, __ATOMIC_RELAXED, __HIP_MEMORY_SCOPE_AGENT); }
__device__ __forceinline__ unsigned xb_xcc_id() { return (unsigned)__builtin_amdgcn_s_getreg((3 << 11) | 20) & 0xFu; }
#define XB_SPIN(cond, bar) do { unsigned _sp = 0; while (cond) { __builtin_amdgcn_s_sleep(1); \
    if ((++_sp & 255u) == 0u) { if (xb_ld(&(bar)[XB_TMO])) break; if (_sp > XB_SPIN_CAP) { atomicAdd(&(bar)[XB_TMO], 1u); break; } } } } while (0)
struct XcdBarrier { unsigned* bar; unsigned x; volatile LAS unsigned* st; };
__device__ __forceinline__ XcdBarrier xcd_barrier_post(unsigned* bar, volatile LAS unsigned* st) {
    XcdBarrier b; b.bar = bar; b.x = xb_xcc_id(); b.st = st;
    if (threadIdx.x == 0) { (void)xb_add(&bar[XB_XCNT(b.x)], 1u); __hip_atomic_store(&bar[XB_XMAP + blockIdx.x], b.x + 1u, __ATOMIC_RELAXED, __HIP_MEMORY_SCOPE_AGENT); }
    return b;
}
__device__ __forceinline__ void xcd_barrier_complete(unsigned* bar, unsigned x, unsigned& nloc, unsigned& nx) {
    const unsigned G = gridDim.x * gridDim.y * gridDim.z;
    unsigned sum, cnt, mine, sp = 0u;
    for (;;) {
        sum = 0u; cnt = 0u; mine = 0u;
#pragma unroll
        for (unsigned j = 0; j < 16; ++j) { const unsigned c = xb_ld(&bar[XB_XCNT(j)]); sum += c; cnt += (c > 0u) ? 1u : 0u; mine = (j == x) ? c : mine; }
        if (sum == G) break;
        __builtin_amdgcn_s_sleep(1);
        if ((++sp & 255u) == 0u) { if (xb_ld(&bar[XB_TMO])) break; if (sp > XB_SPIN_CAP) { atomicAdd(&bar[XB_TMO], 1u); break; } }
    }
    nloc = mine > 0u ? mine : 1u; nx = cnt > 0u ? cnt : 1u;
}
__device__ __forceinline__ void xcd_barrier(const XcdBarrier& b) {
    asm volatile("s_waitcnt vmcnt(0)" ::: "memory");
    __syncthreads();
    if (threadIdx.x == 0) {
        unsigned* bar = b.bar; asm volatile("" : "+s"(bar));
        __builtin_amdgcn_s_waitcnt(0);
        unsigned nloc = b.st[0], nx = b.st[1];
        if (nloc == 0u) { xcd_barrier_complete(bar, b.x, nloc, nx); b.st[0] = nloc; b.st[1] = nx; }
        const unsigned old = xb_add(&bar[XB_XSUB(b.x)], 1u);
        const unsigned gen = old / nloc;
        if (old + 1u == (gen + 1u) * nloc) {
            __builtin_amdgcn_fence(__ATOMIC_RELEASE, "agent");
            asm volatile("s_waitcnt vmcnt(0)" ::: "memory");
            const unsigned og = xb_add(&bar[XB_TOP], 1u);
            const unsigned tg = og / nx;
            if (og + 1u == (tg + 1u) * nx) xb_add(&bar[XB_TOPGEN], 1u);
            else XB_SPIN(xb_ld(&bar[XB_TOPGEN]) == tg, bar);
            __builtin_amdgcn_fence(__ATOMIC_ACQUIRE, "agent");
            xb_add(&bar[XB_XGEN(b.x)], 1u);
            asm volatile("s_waitcnt vmcnt(0)" ::: "memory");
        } else {
            XB_SPIN(xb_ld(&bar[XB_XGEN(b.x)]) == gen, bar);
            __builtin_amdgcn_fence(__ATOMIC_ACQUIRE, "agent");
            asm volatile("s_waitcnt vmcnt(0)" ::: "memory");
        }
    }
    __syncthreads();
}

__device__ __forceinline__ float wave_sum(float v, int lane) {
#pragma unroll
    for (int o = 1; o < 64; o <<= 1) v += shx(v, o, lane);
    return v;
}
struct MapId { __device__ __forceinline__ int operator()(int d) const { return d; } __device__ __forceinline__ int start64(int n0) const { return n0; } };
struct MapFfnIn { __device__ __forceinline__ int operator()(int d) const { const int blk = d >> 8, r = d & 255, j = blk * 128 + (r & 127); return (r < 128) ? j : DFF + j; }
                  __device__ __forceinline__ int start64(int n0) const { return (*this)(n0); } };
struct MapMixIn { __device__ __forceinline__ int operator()(int d) const {
    if (d < 1024) return d; if (d < 6144) return d + 16; if (d < 6656) return d + 24; if (d < 6672) return 1024 + (d - 6656); if (d < 6680) return 6160 + (d - 6672); return -1; }
                  __device__ __forceinline__ int start64(int n0) const { return n0 < 6656 ? (*this)(n0) : -1; } };
template <class CM>
__device__ __forceinline__ void tr_load(f32x4 (&v)[16], const float* W, int Nsrc, int kb, int nb, int lane, const CM cm) {
    const int k0 = 64 * kb, n0 = 64 * nb; const int s0 = cm.start64(n0);
    if (s0 >= 0) {
        const float* src = W + (size_t)(k0 + (lane >> 4)) * Nsrc + s0 + 4 * (lane & 15);
#pragma unroll
        for (int i = 0; i < 16; ++i) v[i] = *(const f32x4*)(src + (size_t)(4 * i) * Nsrc);
    }
}
template <class CM>
__device__ __forceinline__ void tr_finish(const f32x4 (&v)[16], const float* W, int K, int Nsrc, bf16_t* WT, LAS float* scr, int kb, int nb, int lane, const CM cm, int ktn) {
    const int k0 = 64 * kb, n0 = 64 * nb; const int s0 = cm.start64(n0);
    if (s0 >= 0) {
#pragma unroll
        for (int i = 0; i < 16; ++i) { LAS float* d = scr + (4 * i + (lane >> 4)) * 65 + 4 * (lane & 15); d[0] = v[i][0]; d[1] = v[i][1]; d[2] = v[i][2]; d[3] = v[i][3]; }
    } else {
        const int sc = cm(n0 + lane);
#pragma unroll 8
        for (int kk = 0; kk < 64; ++kk) scr[kk * 65 + lane] = (sc >= 0) ? W[(size_t)(k0 + kk) * Nsrc + sc] : 0.f;
    }
    LDS_WAIT(); asm volatile("" ::: "memory");
    const int c = lane & 7;
#pragma unroll
    for (int j = 0; j < 8; ++j) { const int n = (lane >> 3) + 8 * j; const LAS float* s = scr + (8 * c) * 65 + n;
        u32x4 o; o.x = cvt_pk_bf16(s[0 * 65], s[1 * 65]); o.y = cvt_pk_bf16(s[2 * 65], s[3 * 65]); o.z = cvt_pk_bf16(s[4 * 65], s[5 * 65]); o.w = cvt_pk_bf16(s[6 * 65], s[7 * 65]);
        *(u32x4*)(WT + (ktn ? ((size_t)kb * ktn + (size_t)(n0 + n)) * 64 + 8 * c : (size_t)(n0 + n) * K + k0 + 8 * c)) = o; }
    LDS_WAIT(); asm volatile("" ::: "memory");
}
template <class CM>
__device__ __forceinline__ int transpose_matrix(const float* W, int K, int Nsrc, int Ndst, bf16_t* WT, LAS float* scr, int gw, int NGW, const CM cm, int rot, bool kt = false) {
    const int lane = lane_id();
    const int nblk = Ndst / 64, items = (K / 64) * nblk;
    int it = (gw - rot) & (NGW - 1);
    f32x4 va[16], vb[16];
    if (it < items) tr_load(va, W, Nsrc, it / nblk, it % nblk, lane, cm);
    while (it < items) {
        int nx = it + NGW;
        if (nx < items) tr_load(vb, W, Nsrc, nx / nblk, nx % nblk, lane, cm);
        tr_finish(va, W, K, Nsrc, WT, scr, it / nblk, it % nblk, lane, cm, kt ? Ndst : 0);
        it = nx; nx = it + NGW;
        if (it >= items) break;
        if (nx < items) tr_load(va, W, Nsrc, nx / nblk, nx % nblk, lane, cm);
        tr_finish(vb, W, K, Nsrc, WT, scr, it / nblk, it % nblk, lane, cm, kt ? Ndst : 0);
        it = nx;
    }
    return rot + items;
}
__device__ __forceinline__ size_t xbk(size_t row, int col) { return (size_t)(col >> 6) * ((size_t)M * 64) + row * 64 + (size_t)(col & 63); }
__device__ __forceinline__ void cvt_copy_xb(const float* src, bf16_t* dst, size_t n, size_t gt, size_t NGT) {
    for (size_t i = gt * 8; i < n; i += NGT * 32) { f32x4 a[4], b[4];
#pragma unroll
        for (int u = 0; u < 4; ++u) { const size_t j = i + (size_t)u * NGT * 8; if (j < n) { a[u] = *(const f32x4*)(src + j); b[u] = *(const f32x4*)(src + j + 4); } }
#pragma unroll
        for (int u = 0; u < 4; ++u) { const size_t j = i + (size_t)u * NGT * 8; if (j < n) {
            u32x4 w; w.x = cvt_pk_bf16(a[u][0], a[u][1]); w.y = cvt_pk_bf16(a[u][2], a[u][3]); w.z = cvt_pk_bf16(b[u][0], b[u][1]); w.w = cvt_pk_bf16(b[u][2], b[u][3]); *(u32x4*)(dst + xbk(j / D, (int)(j % D))) = w; } } }
}
__device__ __forceinline__ void cvt_copy(const float* src, bf16_t* dst, size_t n, size_t gt, size_t NGT) {
    for (size_t i = gt * 8; i < n; i += NGT * 32) { f32x4 a[4], b[4];
#pragma unroll
        for (int u = 0; u < 4; ++u) { const size_t j = i + (size_t)u * NGT * 8; if (j < n) { a[u] = *(const f32x4*)(src + j); b[u] = *(const f32x4*)(src + j + 4); } }
#pragma unroll
        for (int u = 0; u < 4; ++u) { const size_t j = i + (size_t)u * NGT * 8; if (j < n) {
            u32x4 w; w.x = cvt_pk_bf16(a[u][0], a[u][1]); w.y = cvt_pk_bf16(a[u][2], a[u][3]); w.z = cvt_pk_bf16(b[u][0], b[u][1]); w.w = cvt_pk_bf16(b[u][2], b[u][3]); *(u32x4*)(dst + j) = w; } } }
}
__device__ __forceinline__ void ln_phase(float* Y, bf16_t* XB, const float* g, const float* b, int gw, int NGW) {
    const int lane = lane_id();
    f32x4 gv[8], bv[8];
#pragma unroll
    for (int j = 0; j < 8; ++j) { gv[j] = *(const f32x4*)(g + 4 * lane + 256 * j); bv[j] = *(const f32x4*)(b + 4 * lane + 256 * j); }
    for (int m = gw; m < M; m += NGW) {
        float* yr = Y + (size_t)m * D + 4 * lane; f32x4 v[8]; float s = 0.f;
#pragma unroll
        for (int j = 0; j < 8; ++j) { v[j] = *(const f32x4*)(yr + 256 * j); s += (v[j][0] + v[j][1]) + (v[j][2] + v[j][3]); }
        const float mean = wave_sum(s, lane) * (1.f / D); float s2 = 0.f;
#pragma unroll
        for (int j = 0; j < 8; ++j) { v[j] = v[j] - mean; s2 += (v[j][0] * v[j][0] + v[j][1] * v[j][1]) + (v[j][2] * v[j][2] + v[j][3] * v[j][3]); }
        const float rstd = 1.f / sqrtf(wave_sum(s2, lane) * (1.f / D) + LN_EPS);
        bf16_t* xr = XB + (size_t)m * D + 4 * lane;
#pragma unroll
        for (int j = 0; j < 8; ++j) { const f32x4 o = v[j] * rstd * gv[j] + bv[j]; *(f32x4*)(yr + 256 * j) = o;
            u32x2 w; w.x = cvt_pk_bf16(o[0], o[1]); w.y = cvt_pk_bf16(o[2], o[3]); *(u32x2*)(xr + 256 * j) = w; }
    }
}
struct WqkOrder { int c;
    __device__ bool next(int i, pg8::Unit& u) const { if (i != 0 || c < 0 || c >= 128) return false; const int pn = c & 7, bh = c >> 3, b = bh >> 2, h = bh & 3;
        u.pm = bh; u.pn = pn; u.aoff = (unsigned)(b * NMEM) * 4096u + h * 512; u.boff = (unsigned)(pn * 256) * 2048u + h * 512; u.coff = (unsigned)(b * 1024 + h * 256) * 2048u + pn * 256; return true; } };
struct VwoOrder { int c;
    __device__ bool next(int i, pg8::Unit& u) const { if (i != 0 || c < 0 || c >= 128) return false; const int pm = c & 7, bh = c >> 3, b = bh >> 2, h = bh & 3;
        u.pm = pm; u.pn = bh; u.aoff = (unsigned)(pm * 256) * 2048u + h * 512; u.boff = (unsigned)(b * NMEM) * 4096u + 2048 + h * 512; u.coff = (unsigned)(b * 2048 + pm * 256) * 1024u + h * 256; return true; } };
struct XsOrder { pg8::StaticOrder S;
    __device__ bool next(int i, pg8::Unit& u) const { if (!S.next(i, u)) return false; u.boff = (unsigned)((u.pm >> 5) * 1024 + u.pn * 256) * 2048u; return true; } };

struct Args { const float* in[21]; float* out; unsigned char* ws; };
enum { I_X = 0, I_MEM, I_LNG, I_LNB, I_FWI, I_FWO, I_WIN, I_WOUT, I_GGW, I_GGB, I_GNG, I_HLB, I_HNG, I_DLAM, I_DNG, I_T5, I_MCW, I_MGB, I_XWQ, I_XWKV, I_XWO };

struct Ctx {
    LAS unsigned char* lds; int wave, G, bx, gw, NGW; unsigned* ctl; unsigned char* ws; float* out;
};

#define GRID_BAR() xcd_barrier(bar)
__device__ __forceinline__ void xcd_local_setup(const XcdBarrier& b) {
    const unsigned t = threadIdx.x; bool ok = true;
    if (t < 256u) { const unsigned a = xb_ld(&b.bar[XB_XMAP + t]), r = xb_ld(&b.bar[XB_XMAP + (t & 7u)]); ok = (a == r) && (a != 0u);
        if (t < 8u) { for (unsigned j = 0; j < 8u; ++j) { const unsigned o = xb_ld(&b.bar[XB_XMAP + j]); if (j != t && o == a) ok = false; } } }
    if (threadIdx.x == 0) b.st[2] = (gridDim.x == 256u && b.st[0] == 32u) ? 1u : 0u;
    __syncthreads();
    if (!ok) b.st[2] = 0u;
    __syncthreads();
}
__device__ __forceinline__ void xcd_local_barrier(const XcdBarrier& b) {
    asm volatile("s_waitcnt vmcnt(0)" ::: "memory");
    __syncthreads();
    if (b.st[2] == 0u) { xcd_barrier(b); return; }
    if (threadIdx.x == 0) {
        unsigned* bar = b.bar; asm volatile("" : "+s"(bar));
        __builtin_amdgcn_s_waitcnt(0);
        const unsigned gl = b.st[3]; b.st[3] = gl + 1u;
        (void)__hip_atomic_fetch_add(&bar[XB_LSUB(b.x)], 1u, __ATOMIC_RELAXED, __HIP_MEMORY_SCOPE_AGENT);
        const unsigned target = (gl + 1u) * 32u;
        XB_SPIN(xb_ld(&bar[XB_LSUB(b.x)]) < target, bar);
        __builtin_amdgcn_fence(__ATOMIC_ACQUIRE, "agent");
        asm volatile("s_waitcnt vmcnt(0)" ::: "memory");
    }
    __syncthreads();
}
#define LOCAL_BAR() xcd_local_barrier(bar)
typedef __attribute__((address_space(4))) const Args* KArgsP;
__device__ __forceinline__ KArgsP kargs() { KArgsP p = (KArgsP)__builtin_amdgcn_kernarg_segment_ptr(); asm volatile("" : "+s"(p)); return p; }
#define ARG_IN(i) (kargs()->in[i])
#define ARG_OUT() (kargs()->out)
__device__ __forceinline__ int opq(int x) { asm volatile("" : "+s"(x)); return x; }

namespace mix {
constexpr int PJ = 72;
__device__ __forceinline__ f32x4 mma16(const LAS bf16_t* A, int lda, const LAS bf16_t* Bt, int ldb, int K, f32x4 acc, int lane) {
    const LAS bf16_t* ap = A + (lane & 15) * lda + 8 * (lane >> 4); const LAS bf16_t* bp = Bt + (lane & 15) * ldb + 8 * (lane >> 4);
    for (int k0 = 0; k0 < K; k0 += 32) { const bf16x8 a = *(const LAS bf16x8*)(ap + k0), b = *(const LAS bf16x8*)(bp + k0); acc = __builtin_amdgcn_mfma_f32_16x16x32_bf16(b, a, acc, 0, 0, 0); }
    return acc;
}
template <int CTRL, int RM, bool BC> __device__ __forceinline__ float dppf(float old, float x) {
    return __int_as_float(__builtin_amdgcn_update_dpp(__float_as_int(old), __float_as_int(x), CTRL, RM, 0xf, BC)); }
__device__ __forceinline__ float lane_prefix_sum(float x) {
    x += dppf<0x111, 0xf, true>(0.f, x); x += dppf<0x112, 0xf, true>(0.f, x); x += dppf<0x114, 0xf, true>(0.f, x); x += dppf<0x118, 0xf, true>(0.f, x);
    x += dppf<0x142, 0xa, false>(0.f, x); x += dppf<0x143, 0xc, false>(0.f, x); return x; }
__device__ __forceinline__ float lane_prefix_max(float x) {
    const float NI = -__builtin_inff();
    x = fmaxf(x, dppf<0x111, 0xf, false>(NI, x)); x = fmaxf(x, dppf<0x112, 0xf, false>(NI, x)); x = fmaxf(x, dppf<0x114, 0xf, false>(NI, x)); x = fmaxf(x, dppf<0x118, 0xf, false>(NI, x));
    x = fmaxf(x, dppf<0x142, 0xa, false>(NI, x)); x = fmaxf(x, dppf<0x143, 0xc, false>(NI, x)); return x; }
__device__ __forceinline__ float red32(float x) { auto r = __builtin_amdgcn_permlane32_swap(__float_as_uint(x), __float_as_uint(x), false, false); return __uint_as_float(r[0]) + __uint_as_float(r[1]); }
__device__ __forceinline__ float red16(float x) { auto r = __builtin_amdgcn_permlane16_swap(__float_as_uint(x), __float_as_uint(x), false, false); return __uint_as_float(r[0]) + __uint_as_float(r[1]); }
__device__ __forceinline__ float max32(float x) { auto r = __builtin_amdgcn_permlane32_swap(__float_as_uint(x), __float_as_uint(x), false, false); return fmaxf(__uint_as_float(r[0]), __uint_as_float(r[1])); }
__device__ __forceinline__ float rdlane(float x, int l) { return __int_as_float(__builtin_amdgcn_readlane(__float_as_int(x), l)); }
__device__ __forceinline__ float wsum(float v, int lane) {
#pragma unroll
    for (int o = 1; o < 64; o <<= 1) v += shx(v, o, lane);
    return v;
}
__device__ __forceinline__ float expc(float x) { return fast_exp(fminf(x, 80.f)); }
typedef short v4i16_t __attribute__((ext_vector_type(4)));
__device__ __forceinline__ bf16x8 tr_frag(const LAS bf16_t* base, int pitch, int k0, int c0, int lane) {
    const LAS bf16_t* p = base + (k0 + 8 * (lane >> 4) + ((lane & 15) >> 2)) * pitch + c0 + 4 * (lane & 3);
    const s16x4 lo = __builtin_bit_cast(s16x4, __builtin_amdgcn_ds_read_tr16_b64_v4i16((LAS v4i16_t*)p));
    const s16x4 hi = __builtin_bit_cast(s16x4, __builtin_amdgcn_ds_read_tr16_b64_v4i16((LAS v4i16_t*)(p + 4 * pitch)));
    return (bf16x8){lo[0], lo[1], lo[2], lo[3], hi[0], hi[1], hi[2], hi[3]};
}
__device__ __forceinline__ f32x4 mma16_tb(const LAS bf16_t* A, int lda, const LAS bf16_t* X, int ldx, int n0, int K, f32x4 acc, int lane) {
    const LAS bf16_t* ap = A + (lane & 15) * lda + 8 * (lane >> 4);
    for (int k0 = 0; k0 < K; k0 += 32) { const bf16x8 a = *(const LAS bf16x8*)(ap + k0), b = tr_frag(X, ldx, k0, n0, lane); acc = __builtin_amdgcn_mfma_f32_16x16x32_bf16(b, a, acc, 0, 0, 0); }
    return acc;
}
__device__ __forceinline__ f32x4 mma16_tt(const LAS bf16_t* Y, int ldy, int m0, const LAS bf16_t* X, int ldx, int n0, int K, f32x4 acc, int lane) {
    for (int k0 = 0; k0 < K; k0 += 32) { const bf16x8 a = tr_frag(Y, ldy, k0, m0, lane), b = tr_frag(X, ldx, k0, n0, lane); acc = __builtin_amdgcn_mfma_f32_16x16x32_bf16(b, a, acc, 0, 0, 0); }
    return acc;
}
#define MIX_BAR() do { asm volatile("s_waitcnt vmcnt(0) lgkmcnt(0)" ::: "memory"); __builtin_amdgcn_s_barrier(); asm volatile("" ::: "memory"); } while (0)
#define MIX_LBAR() do { asm volatile("s_waitcnt lgkmcnt(0)" ::: "memory"); __builtin_amdgcn_s_barrier(); asm volatile("" ::: "memory"); } while (0)

template <int DK> struct GlaPre { static constexpr size_t ARR = (size_t)64 * DK * 2, UNIT = 4 * ARR + DK * 4; };
template <int NQ> struct GlaRaw { u32x4 r[2][NQ]; f32x4 rl[4]; };
template <int DK, bool HGRN>
__device__ __forceinline__ void gla_pre_fetch(GlaRaw<DK / 64>& R, int lane, const bf16_t* PROJ, const float* GATES, int b, int h, int c, int w) {
    constexpr int NQ = DK / 64; const int tid = w * 64 + lane;
    const bf16_t* pb = PROJ + ((size_t)b * SEQ + (size_t)c * 64) * PJW + pjcol(HGRN ? PQ_B + h * 128 : PQ_A + h * 64);
#pragma unroll
    for (int a = 0; a < 2; ++a)
#pragma unroll
        for (int i = 0; i < NQ; ++i) { const int q = tid + 512 * i, r_ = q / (DK / 8), col = 8 * (q % (DK / 8)); R.r[a][i] = *(const u32x4*)(pb + (size_t)r_ * PJW + (size_t)a * ((HGRN ? 2 : 1) * (size_t)M * PJW) + col); }
    if (!HGRN) { const float* pg = GATES + ((size_t)b * SEQ + (size_t)c * 64 + lane) * 32;
#pragma unroll
        for (int i = 0; i < 4; ++i) R.rl[i] = *(const f32x4*)(pg + 4 * i); }
}
template <int DK, bool HGRN>
__device__ __forceinline__ void gla_pre_item(LAS unsigned char* lds, GlaRaw<DK / 64>& R, bool has_next, int bn, int hn, int cn, int lane, const bf16_t* PROJ, const float* GATES, unsigned char* PRE, int b, int h, int c, int w,
                                             const float* gate_w, const float* gate_b, const float* hlb0, const float* hlb1, int layer) {
    constexpr int CH = DK / 8, NQ = CH / 8;
    const int d0 = w * CH; const bool lo = lane < 32;
    u32x4 rq[NQ], rk[NQ]; f32x4 rl[4];
    constexpr int PL = DK + 8;
    {
        LAS bf16_t* sin = (LAS bf16_t*)(lds + 73728); const int tid = w * 64 + lane;
#pragma unroll
        for (int a = 0; a < 2; ++a)
#pragma unroll
            for (int i = 0; i < NQ; ++i) { const int q = tid + 512 * i, r_ = q / (DK / 8), col = 8 * (q % (DK / 8)); *(LAS u32x4*)(sin + (a * 64 + r_) * PL + col) = R.r[a][i]; }
#pragma unroll
        for (int i = 0; i < 4; ++i) rl[i] = R.rl[i];
        if (has_next) gla_pre_fetch<DK, HGRN>(R, lane, PROJ, GATES, bn, hn, cn, w);
        MIX_LBAR();
#pragma unroll
        for (int i = 0; i < NQ; ++i) { rq[i] = *(const LAS u32x4*)(sin + lane * PL + d0 + 8 * i); rk[i] = *(const LAS u32x4*)(sin + (64 + lane) * PL + d0 + 8 * i); }
    }
    float qv[CH], kv[CH], cum[CH];
#pragma unroll
    for (int i = 0; i < CH; ++i) {
        const unsigned wq = rq[i >> 3][(i >> 1) & 3], wk = rk[i >> 3][(i >> 1) & 3];
        const float qraw = (i & 1) ? bfhi(wq) : bflo(wq), kraw = (i & 1) ? bfhi(wk) : bflo(wk);
        float g;
        if (HGRN) { float lbv = 0.f; if (layer == 1) { const int ch = h * DK + d0 + i; lbv = sigmoidf_(hlb1[ch] - hlb0[ch]); lbv = fminf(fmaxf(lbv, 0.f), 1.f - 1e-6f); }
            const float sg = sigmoidf_(kraw); g = __logf(fmaxf(lbv, 1e-12f) + (1.f - lbv) * sg); qv[i] = siluf_(qraw) * 0.08838834764831845f; kv[i] = (1.f - lbv) * (1.f - sg); }
        else { float a = gate_b[h * 64 + d0 + i];
#pragma unroll
            for (int r = 0; r < 16; ++r) a += rl[r >> 2][r & 3] * gate_w[r * 256 + h * 64 + d0 + i];
            g = logsigmoidf_(a) * 0.0625f; qv[i] = qraw * 0.125f; kv[i] = kraw; }
        cum[i] = lane_prefix_sum(g);
    }
    unsigned pqa[CH / 2], pq2[CH / 2], pkb[CH / 2], pks[CH / 2]; float decv = 0.f;
#pragma unroll
    for (int i = 0; i < CH; i += 2) {
        float e0[2], e2[2], ek[2], es[2];
#pragma unroll
        for (int j = 0; j < 2; ++j) { const float cm = cum[i + j], c31 = rdlane(cm, 31);
            const float e1 = fast_exp(fmaxf(lo ? cm : cm - c31, -80.f)), k1 = fast_exp(fminf(c31 - cm, 80.f));
            const float E0 = rdlane(e1, 31), E63 = fast_rcp(rdlane(k1, 63));
            e0[j] = qv[i + j] * (lo ? e1 : e1 * E0); e2[j] = lo ? kv[i + j] * fast_rcp(e1) : qv[i + j] * e1; ek[j] = kv[i + j] * k1; es[j] = ek[j] * E63;
            decv = (lane == i + j) ? E0 * E63 : decv; }
        pqa[i >> 1] = cvt_pk_bf16_c(e0[0], e0[1]); pq2[i >> 1] = cvt_pk_bf16_c(e2[0], e2[1]); pkb[i >> 1] = cvt_pk_bf16_c(ek[0], ek[1]); pks[i >> 1] = cvt_pk_bf16_c(es[0], es[1]);
    }
    unsigned char* un = PRE + (size_t)((b * 4 + h) * (SEQ / 64) + c) * GlaPre<DK>::UNIT;
    LAS bf16_t* sl = (LAS bf16_t*)lds + lane * PL + d0;
#pragma unroll
    for (int i = 0; i < NQ; ++i) {
        *(LAS u32x4*)(sl + 8 * i) = (u32x4){pqa[4 * i], pqa[4 * i + 1], pqa[4 * i + 2], pqa[4 * i + 3]};
        *(LAS u32x4*)(sl + 64 * PL + 8 * i) = (u32x4){pq2[4 * i], pq2[4 * i + 1], pq2[4 * i + 2], pq2[4 * i + 3]};
        *(LAS u32x4*)(sl + 2 * 64 * PL + 8 * i) = (u32x4){pkb[4 * i], pkb[4 * i + 1], pkb[4 * i + 2], pkb[4 * i + 3]};
        *(LAS u32x4*)(sl + 3 * 64 * PL + 8 * i) = (u32x4){pks[4 * i], pks[4 * i + 1], pks[4 * i + 2], pks[4 * i + 3]};
    }
    if (lane < CH) ((float*)(un + 4 * GlaPre<DK>::ARR))[d0 + lane] = decv;
    MIX_LBAR();
    { const int tid = w * 64 + lane;
#pragma unroll
        for (int a = 0; a < 4; ++a)
#pragma unroll
            for (int i = 0; i < NQ; ++i) { const int q = tid + 512 * i, row = q / (DK / 8), col = 8 * (q % (DK / 8));
                ((u32x4*)(un + a * GlaPre<DK>::ARR))[q] = *(const LAS u32x4*)((LAS bf16_t*)lds + (a * 64 + row) * PL + col); } }
    MIX_LBAR();
}

template <int NQ> struct GlaRegs { u32x4 ra[NQ], r2[NQ], rb[NQ], rs_[NQ], rv[2]; float rdec; u32x2 g[4]; };
template <int DK, bool HGRN>
struct GlaStream {
    static constexpr int P = DK + 8, PV = 136, CH = DK / 8, NQ = CH / 8, ND = DK / 16;
    LAS bf16_t *qa, *qb, *ka, *kb, *ks, *vv, *ST, *at; LAS float *dec, *rsum;
    int wave, lane, tid, fq, fr, vbase, gcol, ocol; f32x4 ng; const bf16_t* PROJ; bf16_t* MIXED; const unsigned char* pre0; size_t row0;
    f32x4 sacc[ND];
    __device__ __forceinline__ void load(GlaRegs<NQ>& R, int c) const {
        const unsigned char* un_ = pre0 + (size_t)c * GlaPre<DK>::UNIT; const u32x4* pa_ = (const u32x4*)un_ + tid;
#pragma unroll
        for (int i = 0; i < NQ; ++i) { R.ra[i] = pa_[512 * i]; R.r2[i] = pa_[64 * DK / 8 + 512 * i]; R.rb[i] = pa_[2 * (64 * DK / 8) + 512 * i]; R.rs_[i] = pa_[3 * (64 * DK / 8) + 512 * i]; }
        R.rdec = (tid < DK) ? ((const float*)(un_ + 4 * GlaPre<DK>::ARR))[tid] : 0.f;
#pragma unroll
        for (int i = 0; i < 2; ++i) { const int q_ = tid + 512 * i; R.rv[i] = *(const u32x4*)(PROJ + (row0 + (size_t)c * 64 + (q_ >> 4)) * PJW + pjcol(vbase) + 8 * (q_ & 15)); }
#pragma unroll
        for (int tt = 0; tt < 4; ++tt) R.g[tt] = *(const u32x2*)(PROJ + (row0 + (size_t)c * 64 + 16 * tt + fr) * PJW + pjcol(gcol));
    }
    __device__ __forceinline__ void chunk(GlaRegs<NQ>& R, int c) {
#pragma unroll
        for (int i = 0; i < NQ; ++i) { const int q = tid + 512 * i, row = q / (DK / 8), col = 8 * (q % (DK / 8));
            *(LAS u32x4*)(qa + row * P + col) = R.ra[i]; *(LAS u32x4*)(kb + row * P + col) = R.rb[i]; *(LAS u32x4*)(ks + row * P + col) = R.rs_[i];
            *(LAS u32x4*)((row < 32 ? ka + row * P : qb + (row - 32) * P) + col) = R.r2[i]; }
        if (tid < DK) dec[tid] = R.rdec;
#pragma unroll
        for (int i = 0; i < 2; ++i) { const int q = tid + 512 * i; *(LAS u32x4*)(vv + (q >> 4) * PV + 8 * (q & 15)) = R.rv[i]; }
        u32x2 gt[4];
#pragma unroll
        for (int tt = 0; tt < 4; ++tt) gt[tt] = R.g[tt];
        if (c + 2 < SEQ / 64) load(R, c + 2);
        MIX_LBAR();
        f32x4 oacc[4];
        {
            const int ti = wave >> 1, tj0 = 2 * (wave & 1); const bool act0 = tj0 <= ti, act1 = tj0 + 1 <= ti;
            f32x4 sa0 = (f32x4){0.f, 0.f, 0.f, 0.f}, sa1 = sa0;
#pragma unroll
            for (int tt = 0; tt < 4; ++tt) oacc[tt] = (f32x4){0.f, 0.f, 0.f, 0.f};
            const LAS bf16_t* pq = qa + fr * P + 8 * fq; const LAS bf16_t* pst = ST + (16 * wave + fr) * P + 8 * fq;
            const LAS bf16_t* psa = ((ti < 2) ? qa + 16 * ti * P : qb + 16 * (ti - 2) * P) + fr * P + 8 * fq; const LAS bf16_t* psb = ((ti < 2) ? ka : kb) + (16 * tj0 + fr) * P + 8 * fq;
#pragma unroll
            for (int k0 = 0; k0 < DK; k0 += 32) {
                const bf16x8 bst = *(const LAS bf16x8*)(pst + k0); bf16x8 aq[4];
#pragma unroll
                for (int tt = 0; tt < 4; ++tt) aq[tt] = *(const LAS bf16x8*)(pq + 16 * tt * P + k0);
#pragma unroll
                for (int tt = 0; tt < 4; ++tt) oacc[tt] = __builtin_amdgcn_mfma_f32_16x16x32_bf16(bst, aq[tt], oacc[tt], 0, 0, 0);
                if (act0) { const bf16x8 as_ = *(const LAS bf16x8*)(psa + k0), b0 = *(const LAS bf16x8*)(psb + k0); sa0 = __builtin_amdgcn_mfma_f32_16x16x32_bf16(b0, as_, sa0, 0, 0, 0);
                    if (act1) { const bf16x8 b1 = *(const LAS bf16x8*)(psb + 16 * P + k0); sa1 = __builtin_amdgcn_mfma_f32_16x16x32_bf16(b1, as_, sa1, 0, 0, 0); } }
            }
            if (tj0 == ti) {
#pragma unroll
                for (int r = 0; r < 4; ++r) if (4 * fq + r > fr) sa0[r] = 0.f; }
            if (tj0 + 1 == ti) {
#pragma unroll
                for (int r = 0; r < 4; ++r) if (4 * fq + r > fr) sa1[r] = 0.f; }
            u32x2 w; w.x = cvt_pk_bf16_c(sa0[0], sa0[1]); w.y = cvt_pk_bf16_c(sa0[2], sa0[3]); *(LAS u32x2*)(at + (16 * ti + fr) * PJ + 16 * tj0 + 4 * fq) = w;
            w.x = cvt_pk_bf16_c(sa1[0], sa1[1]); w.y = cvt_pk_bf16_c(sa1[2], sa1[3]); *(LAS u32x2*)(at + (16 * ti + fr) * PJ + 16 * tj0 + 16 + 4 * fq) = w;
        }
        MIX_LBAR();
        {
#pragma unroll
            for (int dt = 0; dt < ND; ++dt) { const f32x4 dv = *(const LAS f32x4*)(dec + 16 * dt + 4 * fq); sacc[dt] = sacc[dt] * dv; }
#pragma unroll
            for (int k0 = 0; k0 < 64; k0 += 32) {
                const bf16x8 vf = tr_frag(vv, PV, k0, 16 * wave, lane);
#pragma unroll
                for (int tt = (k0 ? 2 : 0); tt < 4; ++tt) { const bf16x8 af = *(const LAS bf16x8*)(at + (16 * tt + fr) * PJ + k0 + 8 * fq); oacc[tt] = __builtin_amdgcn_mfma_f32_16x16x32_bf16(vf, af, oacc[tt], 0, 0, 0); }
#pragma unroll
                for (int dt = 0; dt < ND; ++dt) { const bf16x8 kf = tr_frag(ks, P, k0, 16 * dt, lane); sacc[dt] = __builtin_amdgcn_mfma_f32_16x16x32_bf16(kf, vf, sacc[dt], 0, 0, 0); }
            }
#pragma unroll
            for (int dt = 0; dt < ND; ++dt) { u32x2 w; w.x = cvt_pk_bf16_c(sacc[dt][0], sacc[dt][1]); w.y = cvt_pk_bf16_c(sacc[dt][2], sacc[dt][3]); *(LAS u32x2*)(ST + (16 * wave + fr) * P + 16 * dt + 4 * fq) = w; }
#pragma unroll
            for (int tt = 0; tt < 4; ++tt) { float s = (oacc[tt][0] * oacc[tt][0] + oacc[tt][1] * oacc[tt][1]) + (oacc[tt][2] * oacc[tt][2] + oacc[tt][3] * oacc[tt][3]);
                s = red16(s); s = red32(s); if (fq == 0) rsum[(16 * tt + fr) * 8 + wave] = s; }
        }
        MIX_LBAR();
#pragma unroll
        for (int tt = 0; tt < 4; ++tt) { const f32x4 t0 = *(const LAS f32x4*)(rsum + (16 * tt + fr) * 8), t1 = *(const LAS f32x4*)(rsum + (16 * tt + fr) * 8 + 4);
            const float tot = ((t0[0] + t0[1]) + (t0[2] + t0[3])) + ((t1[0] + t1[1]) + (t1[2] + t1[3]));
            const float rstd = __builtin_amdgcn_rsqf(tot * (1.f / 128.f) + LN_EPS);
            const float g0 = bflo(gt[tt].x), g1 = bfhi(gt[tt].x), g2 = bflo(gt[tt].y), g3 = bfhi(gt[tt].y);
            const f32x4 o = oacc[tt] * rstd * ng;
            u32x2 w; w.x = cvt_pk_bf16_c(o[0] * siluf_(g0), o[1] * siluf_(g1)); w.y = cvt_pk_bf16_c(o[2] * siluf_(g2), o[3] * siluf_(g3));
            *(u32x2*)(MIXED + (row0 + (size_t)c * 64 + 16 * tt + fr) * 64 + ocol) = w; }
    }
};
template <int DK, bool HGRN>
__device__ __forceinline__ void gla_stream(LAS unsigned char* lds, int wave, int lane, const bf16_t* PROJ, const unsigned char* PRE, bf16_t* MIXED, int b, int h, const float* norm_g) {
    GlaStream<DK, HGRN> G; constexpr int P = DK + 8, PV = 136, NQ = DK / 64, ND = DK / 16;
    G.qa = (LAS bf16_t*)lds; G.qb = G.qa + 64 * P; G.ka = G.qb + 32 * P; G.kb = G.ka + 32 * P; G.ks = G.kb + 64 * P; G.vv = G.ks + 64 * P; G.ST = G.vv + 64 * PV; G.at = G.ST + 128 * P;
    G.dec = (LAS float*)(G.at + 64 * PJ); G.rsum = G.dec + DK;
    static_assert((size_t)((64 + 32 + 32 + 64 + 64 + 128) * P + 64 * PV + 64 * PJ) * 2 + (DK + 512) * 4 <= 160 * 1024 - 1024, "stream LDS map");
    G.wave = wave; G.lane = lane; G.tid = wave * 64 + lane; G.fq = lane >> 4; G.fr = lane & 15;
    for (int i = G.tid; i < 128 * P / 2; i += 512) ((LAS unsigned*)G.ST)[i] = 0u;
#pragma unroll
    for (int i = 0; i < ND; ++i) G.sacc[i] = (f32x4){0.f, 0.f, 0.f, 0.f};
    G.ng = *(const f32x4*)(norm_g + 16 * wave + 4 * G.fq);
    G.vbase = (HGRN ? PI_B : PV_A) + h * 128; G.gcol = (HGRN ? PG_B : PR_A) + h * 128 + 16 * wave + 4 * G.fq; G.ocol = ktm((HGRN ? 512 : 0) + h * 128 + 16 * wave + 4 * G.fq);
    G.row0 = (size_t)b * SEQ; G.PROJ = PROJ; G.MIXED = MIXED;
    G.pre0 = PRE + (size_t)((b * 4 + h) * (SEQ / 64)) * GlaPre<DK>::UNIT;
    GlaRegs<NQ> RA, RB;
    G.load(RA, 0); G.load(RB, 1);
    MIX_BAR();
    for (int c = 0; c < SEQ / 64; c += 2) { G.chunk(RA, c); G.chunk(RB, c + 1); }
    MIX_BAR();
}

constexpr size_t ML_ARR = 64 * 64 * 2, ML_UNIT = 3 * ML_ARR + 4 * 256;
struct MlRaw { u32x4 r[2][2]; float gi, gf; };
__device__ __forceinline__ void mlstm_pre_fetch(MlRaw& R, int lane, const bf16_t* PROJ, const float* GATES, int b, int h, int c, int w) {
    const int tid = w * 64 + lane; const size_t row0 = (size_t)b * SEQ;
#pragma unroll
    for (int a = 0; a < 2; ++a)
#pragma unroll
        for (int i = 0; i < 2; ++i) { const int q = tid + 512 * i; u32x4 v = (u32x4){0u, 0u, 0u, 0u};
            if (q < 67 * 8) { const int r_ = q >> 3, col = 8 * (q & 7), t = c * 64 - 3 + r_; if (t >= 0) v = *(const u32x4*)(PROJ + (row0 + (size_t)t) * PJW + pjcol((a ? PK_D : PQ_D) + h * 64) + col); }
            R.r[a][i] = v; }
    const float* pg = GATES + (row0 + (size_t)(c * 64 + lane)) * 32; R.gi = pg[16 + h]; R.gf = pg[20 + h];
}
__device__ __forceinline__ void mlstm_pre_item(LAS unsigned char* lds, MlRaw& R, bool has_next, int bn, int hn, int cn, int lane, const bf16_t* PROJ, const float* GATES, unsigned char* PRE, int b, int h, int c, int w, const float* conv_w, const float* gate_b) {
    const int d0 = w * 8;
    u32x4 rq[4], rk[4]; float gi, gf;
    {
        LAS bf16_t* sin = (LAS bf16_t*)(lds + 73728); const int tid = w * 64 + lane;
#pragma unroll
        for (int a = 0; a < 2; ++a)
#pragma unroll
            for (int i = 0; i < 2; ++i) { const int q = tid + 512 * i; if (q < 67 * 8) *(LAS u32x4*)(sin + (a * 67 + (q >> 3)) * PJ + 8 * (q & 7)) = R.r[a][i]; }
        gi = R.gi; gf = R.gf;
        if (has_next) mlstm_pre_fetch(R, lane, PROJ, GATES, bn, hn, cn, w);
        MIX_LBAR();
#pragma unroll
        for (int j = 0; j < 4; ++j) { rq[j] = *(const LAS u32x4*)(sin + (lane + 3 - j) * PJ + d0); rk[j] = *(const LAS u32x4*)(sin + (67 + lane + 3 - j) * PJ + d0); }
    }
    const float li = gi + gate_b[h], lf = logsigmoidf_(gf + gate_b[4 + h]);
    const float cum = lane_prefix_sum(lf), a = li - cum, pm = lane_prefix_max(a), wloc = fast_exp(a - rdlane(pm, 63));
    unsigned pq[4], pk[4], pw[4]; float nl = 0.f;
#pragma unroll
    for (int i = 0; i < 8; i += 2) { float qc[2], kc[2];
#pragma unroll
        for (int e = 0; e < 2; ++e) { float sq = 0.f, sk = 0.f;
#pragma unroll
            for (int j = 0; j < 4; ++j) { const unsigned wq = rq[j][i >> 1], wkk = rk[j][i >> 1]; const float xq = e ? bfhi(wq) : bflo(wq), xk = e ? bfhi(wkk) : bflo(wkk);
                sq += conv_w[(3 - j) * 512 + h * 64 + d0 + i + e] * xq; sk += conv_w[(3 - j) * 512 + 256 + h * 64 + d0 + i + e] * xk; }
            qc[e] = siluf_(sq); kc[e] = siluf_(sk) * 0.125f;
            const float ns = rdlane(lane_prefix_sum(kc[e] * wloc), 63); nl = (lane == i + e) ? ns : nl; }
        pq[i >> 1] = cvt_pk_bf16_c(qc[0], qc[1]); pk[i >> 1] = cvt_pk_bf16_c(kc[0], kc[1]); pw[i >> 1] = cvt_pk_bf16_c(kc[0] * wloc, kc[1] * wloc); }
    unsigned char* un = PRE + (size_t)((b * 4 + h) * (SEQ / 64) + c) * ML_UNIT;
    LAS bf16_t* sl = (LAS bf16_t*)lds + lane * PJ + d0;
    *(LAS u32x4*)(sl) = (u32x4){pq[0], pq[1], pq[2], pq[3]}; *(LAS u32x4*)(sl + 64 * PJ) = (u32x4){pk[0], pk[1], pk[2], pk[3]}; *(LAS u32x4*)(sl + 2 * 64 * PJ) = (u32x4){pw[0], pw[1], pw[2], pw[3]};
    float* fs = (float*)(un + 3 * ML_ARR);
    if (w == 0) { fs[lane] = a; fs[64 + lane] = pm; fs[128 + lane] = cum; }
    if (lane < 8) fs[192 + d0 + lane] = nl;
    MIX_LBAR();
    { const int tid = w * 64 + lane, row = tid >> 3, col = 8 * (tid & 7);
#pragma unroll
        for (int a3 = 0; a3 < 3; ++a3) ((u32x4*)(un + a3 * ML_ARR))[tid] = *(const LAS u32x4*)((LAS bf16_t*)lds + (a3 * 64 + row) * PJ + col); }
    MIX_LBAR();
}

struct MlRegs { u32x4 rq, rk, rw, rv[2]; float a, pm, cum, pmrow, nl; u32x2 g[4]; };
struct MlStream {
    static constexpr int PV = 136;
    LAS bf16_t *q_, *k_, *ks, *vv, *CT, *sc; LAS float *av, *uv, *mt, *wi, *nst, *qn, *rs;
    int wave, lane, tid, fq, fr, h, gcol, ocol; const bf16_t* PROJ; bf16_t* MIXED; const unsigned char* pre0; size_t row0;
    f32x4 cacc[4]; float m_st;
    __device__ __forceinline__ void load(MlRegs& R, int c) const {
        const unsigned char* un_ = pre0 + (size_t)c * ML_UNIT; const u32x4* pa_ = (const u32x4*)un_ + tid;
        R.rq = pa_[0]; R.rk = pa_[512]; R.rw = pa_[1024];
        const float* fs = (const float*)(un_ + 3 * ML_ARR); R.a = fs[lane]; R.pm = fs[64 + lane]; R.cum = fs[128 + lane]; R.pmrow = fs[64 + (tid >> 3)]; R.nl = fs[192 + (tid & 63)];
#pragma unroll
        for (int i = 0; i < 2; ++i) { const int q = tid + 512 * i; R.rv[i] = *(const u32x4*)(PROJ + (row0 + (size_t)c * 64 + (q >> 4)) * PJW + pjcol(PV_D + h * 128) + 8 * (q & 15)); }
#pragma unroll
        for (int tt = 0; tt < 4; ++tt) R.g[tt] = *(const u32x2*)(PROJ + (row0 + (size_t)c * 64 + 16 * tt + fr) * PJW + pjcol(gcol));
    }
    __device__ __forceinline__ void chunk(MlRegs& R, int c) {
        const float u = fmaxf(m_st, R.pm), w_inter = fast_exp(m_st - u), u63 = rdlane(u, 63), pm63 = rdlane(R.pm, 63), cum63 = rdlane(R.cum, 63);
        const float r63 = fast_exp(pm63 - u63), dec_c = fast_exp(m_st - u63);
        if (wave == 0) { av[lane] = R.a; uv[lane] = u; mt[lane] = R.cum + u; wi[lane] = w_inter; }
        { const int row = tid >> 3, col = 8 * (tid & 7);
            *(LAS u32x4*)(q_ + row * PJ + col) = R.rq; *(LAS u32x4*)(k_ + row * PJ + col) = R.rk; *(LAS u32x4*)(ks + row * PJ + col) = R.rw;
            const f32x4 n0 = *(const LAS f32x4*)(nst + col), n1 = *(const LAS f32x4*)(nst + col + 4);
            const float dot = (bflo(R.rq.x) * n0[0] + bfhi(R.rq.x) * n0[1]) + (bflo(R.rq.y) * n0[2] + bfhi(R.rq.y) * n0[3]) + (bflo(R.rq.z) * n1[0] + bfhi(R.rq.z) * n1[1]) + (bflo(R.rq.w) * n1[2] + bfhi(R.rq.w) * n1[3]);
            qn[row * 8 + (tid & 7)] = dot * fast_exp(m_st - fmaxf(m_st, R.pmrow)); }
#pragma unroll
        for (int i = 0; i < 2; ++i) { const int q = tid + 512 * i; *(LAS u32x4*)(vv + (q >> 4) * PV + 8 * (q & 15)) = R.rv[i]; }
        u32x2 gt[4];
#pragma unroll
        for (int tt = 0; tt < 4; ++tt) gt[tt] = R.g[tt];
        const float nl = R.nl;
        m_st = cum63 + u63;
        if (c + 2 < SEQ / 64) load(R, c + 2);
        MIX_LBAR();
        f32x4 oacc[4];
        {
            const int ti = wave >> 1, tj0 = 2 * (wave & 1); const bool act0 = tj0 <= ti, act1 = tj0 + 1 <= ti;
            f32x4 sa0 = (f32x4){0.f, 0.f, 0.f, 0.f}, sa1 = sa0;
#pragma unroll
            for (int tt = 0; tt < 4; ++tt) oacc[tt] = (f32x4){0.f, 0.f, 0.f, 0.f};
            const LAS bf16_t* pq = q_ + fr * PJ + 8 * fq; const LAS bf16_t* pct = CT + (16 * wave + fr) * PJ + 8 * fq;
            const LAS bf16_t* psb = k_ + (16 * tj0 + fr) * PJ + 8 * fq;
#pragma unroll
            for (int k0 = 0; k0 < 64; k0 += 32) {
                const bf16x8 bct = *(const LAS bf16x8*)(pct + k0); bf16x8 aq[4];
#pragma unroll
                for (int tt = 0; tt < 4; ++tt) aq[tt] = *(const LAS bf16x8*)(pq + 16 * tt * PJ + k0);
#pragma unroll
                for (int tt = 0; tt < 4; ++tt) oacc[tt] = __builtin_amdgcn_mfma_f32_16x16x32_bf16(bct, aq[tt], oacc[tt], 0, 0, 0);
                if (act0) { const bf16x8 as_ = *(const LAS bf16x8*)(pq + 16 * ti * PJ + k0), b0 = *(const LAS bf16x8*)(psb + k0); sa0 = __builtin_amdgcn_mfma_f32_16x16x32_bf16(b0, as_, sa0, 0, 0, 0);
                    if (act1) { const bf16x8 b1 = *(const LAS bf16x8*)(psb + 16 * PJ + k0); sa1 = __builtin_amdgcn_mfma_f32_16x16x32_bf16(b1, as_, sa1, 0, 0, 0); } }
            }
#pragma unroll
            for (int tt = 0; tt < 4; ++tt) oacc[tt] = oacc[tt] * wi[16 * tt + fr];
            const float ui = uv[16 * ti + fr]; const f32x4 aj0 = *(const LAS f32x4*)(av + 16 * tj0 + 4 * fq), aj1 = *(const LAS f32x4*)(av + 16 * tj0 + 16 + 4 * fq);
#pragma unroll
            for (int r = 0; r < 4; ++r) { sa0[r] = (act0 && 16 * tj0 + 4 * fq + r <= 16 * ti + fr) ? sa0[r] * fast_exp(aj0[r] - ui) : 0.f; sa1[r] = (act1 && 16 * tj0 + 16 + 4 * fq + r <= 16 * ti + fr) ? sa1[r] * fast_exp(aj1[r] - ui) : 0.f; }
            float s0 = (sa0[0] + sa0[1]) + (sa0[2] + sa0[3]), s1 = (sa1[0] + sa1[1]) + (sa1[2] + sa1[3]); s0 = red32(red16(s0)); s1 = red32(red16(s1));
            if (fq == 0) { rs[(16 * ti + fr) * 4 + tj0] = s0; rs[(16 * ti + fr) * 4 + tj0 + 1] = s1; }
            u32x2 w; w.x = cvt_pk_bf16_c(sa0[0], sa0[1]); w.y = cvt_pk_bf16_c(sa0[2], sa0[3]); *(LAS u32x2*)(sc + (16 * ti + fr) * PJ + 16 * tj0 + 4 * fq) = w;
            w.x = cvt_pk_bf16_c(sa1[0], sa1[1]); w.y = cvt_pk_bf16_c(sa1[2], sa1[3]); *(LAS u32x2*)(sc + (16 * ti + fr) * PJ + 16 * tj0 + 16 + 4 * fq) = w;
        }
        MIX_LBAR();
        {
            f32x4 tmp[4];
#pragma unroll
            for (int dt = 0; dt < 4; ++dt) tmp[dt] = (f32x4){0.f, 0.f, 0.f, 0.f};
#pragma unroll
            for (int k0 = 0; k0 < 64; k0 += 32) {
                const bf16x8 vf = tr_frag(vv, PV, k0, 16 * wave, lane);
#pragma unroll
                for (int tt = (k0 ? 2 : 0); tt < 4; ++tt) { const bf16x8 af = *(const LAS bf16x8*)(sc + (16 * tt + fr) * PJ + k0 + 8 * fq); oacc[tt] = __builtin_amdgcn_mfma_f32_16x16x32_bf16(vf, af, oacc[tt], 0, 0, 0); }
#pragma unroll
                for (int dt = 0; dt < 4; ++dt) { const bf16x8 kf = tr_frag(ks, PJ, k0, 16 * dt, lane); tmp[dt] = __builtin_amdgcn_mfma_f32_16x16x32_bf16(kf, vf, tmp[dt], 0, 0, 0); }
            }
#pragma unroll
            for (int dt = 0; dt < 4; ++dt) { cacc[dt] = cacc[dt] * dec_c + tmp[dt] * r63;
                u32x2 w; w.x = cvt_pk_bf16_c(cacc[dt][0], cacc[dt][1]); w.y = cvt_pk_bf16_c(cacc[dt][2], cacc[dt][3]); *(LAS u32x2*)(CT + (16 * wave + fr) * PJ + 16 * dt + 4 * fq) = w; }
            if (tid < 64) nst[tid] = dec_c * nst[tid] + r63 * nl;
        }
#pragma unroll
        for (int tt = 0; tt < 4; ++tt) { const int i = 16 * tt + fr;
            const f32x4 q0 = *(const LAS f32x4*)(qn + i * 8), q1 = *(const LAS f32x4*)(qn + i * 8 + 4), r4 = *(const LAS f32x4*)(rs + i * 4);
            const float den = (((q0[0] + q0[1]) + (q0[2] + q0[3])) + ((q1[0] + q1[1]) + (q1[2] + q1[3]))) + ((r4[0] + r4[1]) + (r4[2] + r4[3]));
            const float inv = fast_rcp(fmaxf(fabsf(den), fast_exp(-mt[i])));
            const float g0 = bflo(gt[tt].x), g1 = bfhi(gt[tt].x), g2 = bflo(gt[tt].y), g3 = bfhi(gt[tt].y);
            u32x2 w; w.x = cvt_pk_bf16_c(oacc[tt][0] * inv * sigmoidf_(g0), oacc[tt][1] * inv * sigmoidf_(g1)); w.y = cvt_pk_bf16_c(oacc[tt][2] * inv * sigmoidf_(g2), oacc[tt][3] * inv * sigmoidf_(g3));
            *(u32x2*)(MIXED + (row0 + (size_t)c * 64 + i) * 64 + ocol) = w; }
        MIX_LBAR();
    }
};
__device__ __forceinline__ void mlstm_stream(LAS unsigned char* lds, int wave, int lane, const bf16_t* PROJ, const unsigned char* PRE, bf16_t* MIXED, int b, int h) {
    MlStream G; constexpr int PV = 136;
    G.q_ = (LAS bf16_t*)lds; G.k_ = G.q_ + 64 * PJ; G.ks = G.k_ + 64 * PJ; G.vv = G.ks + 64 * PJ; G.CT = G.vv + 64 * PV; G.sc = G.CT + 128 * PJ;
    G.av = (LAS float*)(G.sc + 64 * PJ); G.uv = G.av + 64; G.mt = G.uv + 64; G.wi = G.mt + 64; G.nst = G.wi + 64; G.qn = G.nst + 64; G.rs = G.qn + 512;
    G.wave = wave; G.lane = lane; G.tid = wave * 64 + lane; G.fq = lane >> 4; G.fr = lane & 15; G.h = h;
    for (int i = G.tid; i < 64; i += 512) G.nst[i] = 0.f;
    for (int i = G.tid; i < 128 * PJ / 2; i += 512) ((LAS unsigned*)G.CT)[i] = 0u;
    G.m_st = 0.f;
#pragma unroll
    for (int i = 0; i < 4; ++i) G.cacc[i] = (f32x4){0.f, 0.f, 0.f, 0.f};
    G.row0 = (size_t)b * SEQ; G.PROJ = PROJ; G.MIXED = MIXED;
    G.gcol = PO_D + h * 128 + 16 * wave + 4 * G.fq; G.ocol = ktm(1536 + h * 128 + 16 * wave + 4 * G.fq);
    G.pre0 = PRE + (size_t)((b * 4 + h) * (SEQ / 64)) * ML_UNIT;
    MlRegs RA, RB;
    G.load(RA, 0); G.load(RB, 1);
    MIX_BAR();
    for (int c = 0; c < SEQ / 64; c += 2) { G.chunk(RA, c); G.chunk(RB, c + 1); }
    MIX_BAR();
}

constexpr int KP = 136, VP = 160, KT_BYTES = 64 * KP * 2, VT_BYTES = 64 * VP * 2, AT_BUF = KT_BYTES + VT_BYTES;
__device__ __forceinline__ int crow(int r, int hi) { return (r & 3) + 8 * (r >> 2) + 4 * hi; }
__device__ __forceinline__ void diff_unit(LAS unsigned char* lds, int wave, int lane, const bf16_t* PROJ, bf16_t* MIXED, int b, int h, int qb, const float* t5, float lam, const float* norm_g, float out_scale) {
    LAS float* btab = (LAS float*)(lds + 2 * AT_BUF);
    LAS float* xch = (LAS float*)lds;
    const int tid = wave * 64 + lane, r32 = lane & 31, hi = lane >> 5, s = wave >> 2, wq = wave & 3;
    const int q0 = qb * 128, NT = 2 * qb + 2;
    const size_t row0 = (size_t)b * SEQ;
    if (tid < 128) { const int n = tid; int bk; if (n < 16) bk = n; else { bk = 16 + (int)(__logf((float)n * 0.0625f) / 2.0794415416798357f * 16.0f); bk = bk < 16 ? 16 : (bk > 31 ? 31 : bk); }
        btab[n] = (t5[bk * 4 + h] - t5[31 * 4 + h]) * 8.0f; }
    bf16x8 qr[4];
    { const bf16_t* qp = PROJ + (row0 + q0 + 32 * wq + r32) * PJW + pjcol(PQ_C + h * 128) + 64 * s + 8 * hi;
#pragma unroll
        for (int d = 0; d < 4; ++d) qr[d] = *(const bf16x8*)(qp + 16 * d); }
    const int srow = tid >> 4, scol = (tid & 15) * 8;
    const bf16_t* kg = PROJ + (row0 + srow) * PJW + pjcol(PK_C + h * 128) + scol; const bf16_t* vg = PROJ + (row0 + srow) * PJW + pjcol(PV_C + h * 128) + scol;
    u32x4 kA[2], vA[2];
#define AT_LOADS(K_, V_, t) do { K_[0] = *(const u32x4*)(kg + (size_t)(64 * (t)) * PJW); K_[1] = *(const u32x4*)(kg + (size_t)(64 * (t) + 32) * PJW); \
                         V_[0] = *(const u32x4*)(vg + (size_t)(64 * (t)) * PJW); V_[1] = *(const u32x4*)(vg + (size_t)(64 * (t) + 32) * PJW); } while (0)
#define AT_STORES(K_, V_, slotoff) do { LAS bf16_t* kt_ = (LAS bf16_t*)(lds + (slotoff)); LAS bf16_t* vt_ = (LAS bf16_t*)(lds + (slotoff) + KT_BYTES); \
                        *(LAS u32x4*)(kt_ + srow * KP + scol) = K_[0]; *(LAS u32x4*)(kt_ + (srow + 32) * KP + scol) = K_[1]; \
                        *(LAS u32x4*)(vt_ + srow * VP + scol) = V_[0]; *(LAS u32x4*)(vt_ + (srow + 32) * VP + scol) = V_[1]; } while (0)
#define AT_QK(P0, P1, slotoff) do { const LAS bf16_t* kp_ = (const LAS bf16_t*)(lds + (slotoff)) + r32 * KP + 64 * s + 8 * hi; \
        _Pragma("unroll") for (int r_ = 0; r_ < 16; ++r_) { P0[r_] = 0.f; P1[r_] = 0.f; } \
        bf16x8 kf_[8];       \
        _Pragma("unroll") for (int d_ = 0; d_ < 4; ++d_) { kf_[2 * d_] = *(const LAS bf16x8*)(kp_ + 16 * d_); kf_[2 * d_ + 1] = *(const LAS bf16x8*)(kp_ + 32 * KP + 16 * d_); } \
        __builtin_amdgcn_sched_barrier(0); \
        _Pragma("unroll") for (int d_ = 0; d_ < 4; ++d_) { \
            P0 = __builtin_amdgcn_mfma_f32_32x32x16_bf16(kf_[2 * d_], qr[d_], P0, 0, 0, 0); P1 = __builtin_amdgcn_mfma_f32_32x32x16_bf16(kf_[2 * d_ + 1], qr[d_], P1, 0, 0, 0); } } while (0)
    { u32x4 kT[2], vT[2];
      AT_LOADS(kT, vT, 0); AT_LOADS(kA, vA, 1); AT_STORES(kT, vT, 0); }
    MIX_LBAR();
    f32x16 o[4];
#pragma unroll
    for (int i = 0; i < 4; ++i)
#pragma unroll
        for (int r = 0; r < 16; ++r) o[i][r] = 0.f;
    float m_run = -1.0e30f, l_run = 0.f;
    const int qpos = q0 + 32 * wq + r32;
    constexpr float SC = 0.125f * LOG2E, THR = 8.0f;
    f32x16 pc0, pc1;
    int sl_cur = 0, sl_nxt = AT_BUF;
#define AT_STEP(T_, LK, LV, SK, SV) do { const int t = (T_); \
        if (t + 1 < NT) AT_STORES(SK, SV, sl_nxt);       \
        if (t + 2 < NT) AT_LOADS(LK, LV, t + 2); \
        AT_QK(pc0, pc1, sl_cur); \
        const LAS bf16_t* vp = (const LAS bf16_t*)(lds + sl_cur + KT_BYTES) + (4 * hi + ((lane & 15) >> 2)) * VP + 16 * ((lane >> 4) & 1) + 4 * (lane & 3); \
        s16x4 vl0[4], vh0[4];        \
        _Pragma("unroll") \
        for (int blk = 0; blk < 4; ++blk) { vl0[blk] = __builtin_bit_cast(s16x4, __builtin_amdgcn_ds_read_tr16_b64_v4i16((LAS v4i16_t*)(vp + 32 * blk))); \
                                            vh0[blk] = __builtin_bit_cast(s16x4, __builtin_amdgcn_ds_read_tr16_b64_v4i16((LAS v4i16_t*)(vp + 8 * VP + 32 * blk))); } \
        __builtin_amdgcn_sched_barrier(0); \
        if (t >= NT - 4) { \
            const int kbase = 64 * t - qpos; \
        _Pragma("unroll") \
            for (int r = 0; r < 16; ++r) { const int rel0 = -(kbase + crow(r, hi)), rel1 = rel0 - 32; \
                pc0[r] = (rel0 >= 0) ? pc0[r] + btab[rel0 > 127 ? 127 : rel0] : -1.0e30f; \
                pc1[r] = (rel1 >= 0) ? pc1[r] + btab[rel1 > 127 ? 127 : rel1] : -1.0e30f; } \
        } \
        pc0 = pc0 * SC; pc1 = pc1 * SC;       \
        float mxa[4]; \
        _Pragma("unroll") \
        for (int q = 0; q < 4; ++q) mxa[q] = fmaxf(fmaxf(pc0[q], pc1[q]), fmaxf(pc0[q + 4], pc1[q + 4])); \
        _Pragma("unroll") \
        for (int q = 0; q < 4; ++q) mxa[q] = fmaxf(mxa[q], fmaxf(fmaxf(pc0[q + 8], pc1[q + 8]), fmaxf(pc0[q + 12], pc1[q + 12]))); \
        float mx = fmaxf(fmaxf(mxa[0], mxa[1]), fmaxf(mxa[2], mxa[3])); \
        mx = max32(mx); \
        if (__any(mx > m_run + THR)) { \
            const float m_new = (mx > m_run + THR) ? mx : m_run, alpha = fast_exp2(m_run - m_new); m_run = m_new; l_run *= alpha; \
        _Pragma("unroll") \
            for (int i = 0; i < 4; ++i) \
        _Pragma("unroll") \
                for (int r = 0; r < 16; ++r) o[i][r] *= alpha; \
        } \
        pc0 = pc0 - m_run; pc1 = pc1 - m_run; \
        f32x4 psa = {0.f, 0.f, 0.f, 0.f}; \
        _Pragma("unroll") \
        for (int r = 0; r < 16; r += 4) { \
        _Pragma("unroll") \
            for (int j = 0; j < 4; ++j) { pc0[r + j] = fast_exp2(pc0[r + j]); pc1[r + j] = fast_exp2(pc1[r + j]); } \
            psa += (f32x4){pc0[r], pc0[r + 1], pc0[r + 2], pc0[r + 3]} + (f32x4){pc1[r], pc1[r + 1], pc1[r + 2], pc1[r + 3]}; } \
        l_run += (psa[0] + psa[1]) + (psa[2] + psa[3]); \
        bf16x8 pf[4]; \
        _Pragma("unroll") \
        for (int ks = 0; ks < 4; ++ks) { unsigned w[4]; \
        _Pragma("unroll") \
            for (int j = 0; j < 4; ++j) { const int r = 8 * (ks & 1) + 2 * j; w[j] = (ks < 2) ? cvt_pk_bf16_c(pc0[r], pc0[r + 1]) : cvt_pk_bf16_c(pc1[r], pc1[r + 1]); } \
            pf[ks] = __builtin_bit_cast(bf16x8, (u32x4){w[0], w[1], w[2], w[3]}); } \
        _Pragma("unroll") \
        for (int ks = 0; ks < 4; ++ks) \
        _Pragma("unroll") \
            for (int blk = 0; blk < 4; ++blk) { \
                const s16x4 lo = (ks == 0) ? vl0[blk] : __builtin_bit_cast(s16x4, __builtin_amdgcn_ds_read_tr16_b64_v4i16((LAS v4i16_t*)(vp + (16 * ks) * VP + 32 * blk))); \
                const s16x4 hh = (ks == 0) ? vh0[blk] : __builtin_bit_cast(s16x4, __builtin_amdgcn_ds_read_tr16_b64_v4i16((LAS v4i16_t*)(vp + (16 * ks + 8) * VP + 32 * blk))); \
                const bf16x8 vf = (bf16x8){lo[0], lo[1], lo[2], lo[3], hh[0], hh[1], hh[2], hh[3]}; \
                o[blk] = __builtin_amdgcn_mfma_f32_32x32x16_bf16(vf, pf[ks], o[blk], 0, 0, 0); \
            } \
        MIX_LBAR(); \
        { const int tmp = sl_cur; sl_cur = sl_nxt; sl_nxt = tmp; } \
    } while (0)
    for (int t2 = 0; t2 < NT; t2 += 2) { AT_STEP(t2, kA, vA, kA, vA); AT_STEP(t2 + 1, kA, vA, kA, vA); }
#undef AT_STEP
    const float l_tot = red32(l_run), inv = 1.0f / l_tot;
    if (s == 1) {
#pragma unroll
        for (int i = 0; i < 4; ++i)
#pragma unroll
            for (int r = 0; r < 16; ++r) xch[(wq * 64 + i * 16 + r) * 64 + lane] = o[i][r] * inv;
    }
    MIX_LBAR();
    if (s == 0) {
        float ss = 0.f;
#pragma unroll
        for (int i = 0; i < 4; ++i)
#pragma unroll
            for (int r = 0; r < 16; ++r) { const float v = o[i][r] * inv - lam * xch[(wq * 64 + i * 16 + r) * 64 + lane]; o[i][r] = v; ss += v * v; }
        ss = red32(ss);
        const float rstd = out_scale / sqrtf(ss * (1.f / 128.f) + LN_EPS);
        int qp2 = qpos; asm volatile("" : "+v"(qp2));
        bf16_t* op = MIXED + (row0 + (size_t)qp2) * 64 + ktm(1024 + h * 128);
#pragma unroll
        for (int i = 0; i < 4; ++i)
#pragma unroll
            for (int g = 0; g < 4; ++g) { const int e = 32 * i + 8 * g + 4 * hi; const f32x4 gn = *(const f32x4*)(norm_g + e);
                u32x2 w; w.x = cvt_pk_bf16_c(o[i][4 * g] * rstd * gn[0], o[i][4 * g + 1] * rstd * gn[1]); w.y = cvt_pk_bf16_c(o[i][4 * g + 2] * rstd * gn[2], o[i][4 * g + 3] * rstd * gn[3]);
                *(u32x2*)(op + (i >> 1) * (M * 64) + (32 * (i & 1) + 8 * g) + 4 * hi) = w; }
    }
    MIX_LBAR();
#undef AT_LOADS
#undef AT_STORES
#undef AT_QK
}
}


template <int l>
__device__ __forceinline__ void mixer_pre_phase(const Ctx& C) {
    const int lane = lane_id();
    const bf16_t* PROJ = (const bf16_t*)(C.ws + WS_UNION); const float* GATES = (const float*)(C.ws + WS_GATES); unsigned char* PRE = C.ws + WS_PRE;
    int gw = C.gw, NGW = C.NGW; asm volatile("" : "+s"(gw), "+s"(NGW));
    (void)NGW;
    const int w = gw & 7, bx = gw >> 3;
    {   mix::MlRaw R; mix::mlstm_pre_fetch(R, lane, PROJ, GATES, (bx >> 7) >> 2, (bx >> 7) & 3, bx & 127, w);
        for (int j = 0; j < 8; ++j) { const int u = bx + 256 * j, un = u + 256;
            mix::mlstm_pre_item(C.lds, R, j + 1 < 8, (un >> 7) >> 2, (un >> 7) & 3, un & 127, lane, PROJ, GATES, PRE + WS_PRE_ML, (u >> 7) >> 2, (u >> 7) & 3, u & 127, w, ARG_IN(I_MCW) + l * 4 * 512, ARG_IN(I_MGB) + l * 8); } }
    {   mix::GlaRaw<2> R; mix::gla_pre_fetch<128, true>(R, lane, PROJ, GATES, (bx >> 7) >> 2, (bx >> 7) & 3, bx & 127, w);
        for (int j = 0; j < 8; ++j) { const int u = bx + 256 * j, un = u + 256;
            mix::gla_pre_item<128, true>(C.lds, R, j + 1 < 8, (un >> 7) >> 2, (un >> 7) & 3, un & 127, lane, PROJ, GATES, PRE + WS_PRE_HGRN, (u >> 7) >> 2, (u >> 7) & 3, u & 127, w, nullptr, nullptr, ARG_IN(I_HLB), ARG_IN(I_HLB) + 512, l); } }
    {   mix::GlaRaw<1> R; mix::gla_pre_fetch<64, false>(R, lane, PROJ, GATES, (bx >> 7) >> 2, (bx >> 7) & 3, bx & 127, w);
        for (int j = 0; j < 8; ++j) { const int u = bx + 256 * j, un = u + 256;
            mix::gla_pre_item<64, false>(C.lds, R, j + 1 < 8, (un >> 7) >> 2, (un >> 7) & 3, un & 127, lane, PROJ, GATES, PRE, (u >> 7) >> 2, (u >> 7) & 3, u & 127, w, ARG_IN(I_GGW) + l * 16 * 256, ARG_IN(I_GGB) + l * 256, nullptr, nullptr, l); } }
}
template <int l>
__device__ __forceinline__ void mixer_phase(const Ctx& C) {
    const int lane = lane_id(); int wave = C.wave; asm volatile("" : "+s"(wave));
    const bf16_t* PROJ = (const bf16_t*)(C.ws + WS_UNION); const float* GATES = (const float*)(C.ws + WS_GATES); bf16_t* MIXED = (bf16_t*)(C.ws + WS_MIXED);
    int bx = C.bx; asm volatile("" : "+s"(bx));
    const unsigned char* PRE = C.ws + WS_PRE;
    if (bx < 16) mix::gla_stream<64, false>(C.lds, wave, lane, PROJ, PRE, MIXED, bx >> 2, bx & 3, ARG_IN(I_GNG) + l * 128);
    else if (bx < 32) mix::gla_stream<128, true>(C.lds, wave, lane, PROJ, PRE + WS_PRE_HGRN, MIXED, (bx - 16) >> 2, bx & 3, ARG_IN(I_HNG) + l * 128);
    else if (bx < 48) mix::mlstm_stream(C.lds, wave, lane, PROJ, PRE + WS_PRE_ML, MIXED, (bx - 32) >> 2, bx & 3);
    const float lambda_init = (l == 0) ? 0.2f : 0.35550906759096934f;
    float lam;
    { const float* dl = ARG_IN(I_DLAM) + l * 256; const float s1 = mix::wsum(dl[lane] * dl[64 + lane], lane), s2 = mix::wsum(dl[128 + lane] * dl[192 + lane], lane); lam = __expf(s1) - __expf(s2) + lambda_init; }
    LAS unsigned* wq = (LAS unsigned*)(C.lds + LDSCTL_OFF + 64);
    const int xg = bx & 7;
    unsigned* ctr = C.ctl + CW_WQ + 64 * (l * 8 + xg);
    for (;;) {
        if (wave == 0 && lane == 0) *wq = __hip_atomic_fetch_add(ctr, 1u, __ATOMIC_RELAXED, __HIP_MEMORY_SCOPE_AGENT);
        MIX_BAR();
        const unsigned u = *wq;
        MIX_LBAR();
        if (u >= 128u) break;
        const int bh = 2 * xg + (int)(u & 1u);
        mix::diff_unit(C.lds, wave, lane, PROJ, MIXED, bh >> 2, bh & 3, 63 - (int)(u >> 1), ARG_IN(I_T5), lam, ARG_IN(I_DNG) + l * 128, 1.0f - lambda_init);
    }
}


template <int LDK, bool FIRST, bool LAST>
__device__ __forceinline__ void gemm_ln_phase(const Ctx& C, const bf16_t* A, const bf16_t* Bt, float s, const float* g, const float* b, int inst, unsigned bbatch = 0u) {
    bf16_t* XB = (bf16_t*)(C.ws + WS_XB); bf16_t* XBOUT = XB;
    constexpr bool AKT = true;
    constexpr bool BKT = (LDK != 1024);
    pg8::Gemm gm{A, Bt}; pg8::PanelOrder4 S{opq(C.bx), AKT ? 64 : LDK, BKT ? 64 : LDK, bbatch, 1};
    pg8::PanelStats8 st{(unsigned long long*)(C.ws + WS_XSLOT), C.ctl + CW_SEAM + inst * SEAM_BANK, C.ctl + CW_TMO};
    pg8::EpiLnRes<FIRST, LAST, false> E{FIRST ? ARG_IN(I_X) : nullptr, C.out, XB, XBOUT, g, b, s, st};
    pg8::gemm_phase<AKT ? 64 : LDK, BKT ? 64 : LDK, LDK, decltype(E), decltype(S), AKT ? M * 64 : 0, BKT ? D * 64 : 0>(C.lds, C.wave, gm, S, E);
}

struct RevNOrder { pg8::StaticOrder S;
    __device__ bool next(int i, pg8::Unit& u) const { if (!S.next(i, u)) return false; u.pn = S.nN - 1 - u.pn;
        u.boff = (unsigned)(u.pn * pg8::BM) * (unsigned)S.ldb; u.coff = (unsigned)(u.pm * pg8::BM) * (unsigned)S.ldc + (unsigned)(u.pn * S.cw); return true; } };
template <bool FIRST, bool LAST, bool LOCAL_END = false>
__device__ __forceinline__ void ffn_block(const Ctx& C, const XcdBarrier& bar, const bf16_t* wfi, const bf16_t* wfo, const float* lng, const float* lnb, int inst) {
    bf16_t* XB = (bf16_t*)(C.ws + WS_XB); bf16_t* H = (bf16_t*)(C.ws + WS_UNION);
    {
        pg8::Gemm g{XB, wfi}; RevNOrder S; S.S.init(M, 2 * DFF, opq(C.G), opq(C.bx), 64, 64, DFF, 128);
        pg8::EpiSwiGLUkt E{H};
        pg8::gemm_phase<64, 64, D, decltype(E), decltype(S), M * 64, 2 * DFF * 64>(C.lds, C.wave, g, S, E);
    }
    LOCAL_BAR();
    gemm_ln_phase<DFF, FIRST, LAST>(C, H, wfo, 0.5f, lng, lnb, inst);
    if (!LAST) { if (LOCAL_END) LOCAL_BAR(); else GRID_BAR(); }
}

template <int l> __device__ __forceinline__ void layer_body(const Ctx& C, const XcdBarrier& bar) {
    unsigned char* ws = C.ws; bf16_t* XB = (bf16_t*)(ws + WS_XB);
        const float* lng = ARG_IN(I_LNG) + (size_t)l * 4 * D; const float* lnb = ARG_IN(I_LNB) + (size_t)l * 4 * D;
        ffn_block<l == 0, false>(C, bar, (const bf16_t*)(ws + WS_WFI + (size_t)(l * 2 + 0) * SZ_WFI), (const bf16_t*)(ws + WS_WFO + (size_t)(l * 2 + 0) * SZ_WFO), lng, lnb, l * 4 + 0);
        {
            pg8::Gemm g{XB, (const bf16_t*)(ws + WS_WMI + l * SZ_WMI)}; pg8::StaticOrder S; S.init(M, NPROJ, opq(C.G), opq(C.bx), 64, 64, PJW, M * PJW);
            pg8::EpiBf16 E{(bf16_t*)(ws + WS_UNION), PJW, 1.0f, (float*)(ws + WS_GATES), 26};
            pg8::gemm_phase<64, 64, D, decltype(E), decltype(S), M * 64, NPROJ * 64>(C.lds, C.wave, g, S, E);
        }
        if constexpr (l == 0) {
            const int cc = opq(C.bx) - 128, ll = cc >> 6;
            pg8::Gemm g{(const bf16_t*)(ws + WS_MEMB), (const bf16_t*)(ws + WS_WXKV + (size_t)(ll & 1) * SZ_WKV)}; pg8::StaticOrder S; S.init(BATCH * NMEM, 2 * D, 1 << 20, cc < 0 ? -1 : (cc & 63), D, D, 2 * D, 256);
            pg8::EpiBf16 E{(bf16_t*)(ws + WS_KB + (size_t)(ll & 1) * BATCH * NMEM * 2 * D * 2), 2 * D, 1.0f, nullptr, -1};
            pg8::gemm_phase<D, D, D>(C.lds, C.wave, g, S, E);
        }
        if constexpr (l == 1) {
            const bf16_t* kv = (const bf16_t*)(ws + WS_KB + (size_t)l * BATCH * NMEM * 2 * D * 2);
            { pg8::Gemm g{kv, (const bf16_t*)(ws + WS_WXQ + l * SZ_WDD)}; WqkOrder S{opq(C.bx) - 128};
              pg8::EpiBf16 E{(bf16_t*)(ws + WS_WFI + UN_WQK), D, 0.04419417382415922f * LOG2E, nullptr, -1};
              pg8::gemm_phase<2 * D, D, 512>(C.lds, C.wave, g, S, E); }
            { pg8::Gemm g{(const bf16_t*)(ws + WS_WXO + l * SZ_WDD), kv}; VwoOrder S{opq(C.bx) - 128};
              pg8::EpiBf16 E{(bf16_t*)(ws + WS_WFI + UN_VWO), 1024, 1.0f, nullptr, -1};
              pg8::gemm_phase<D, 2 * D, 512>(C.lds, C.wave, g, S, E); }
        }
        GRID_BAR();
        mixer_pre_phase<l>(C);
        GRID_BAR();
        if constexpr (l == 0) {
            const bf16_t* kv = (const bf16_t*)(ws + WS_KB + (size_t)l * BATCH * NMEM * 2 * D * 2);
            { pg8::Gemm g{kv, (const bf16_t*)(ws + WS_WXQ + l * SZ_WDD)}; WqkOrder S{opq(C.bx)};
              pg8::EpiBf16 E{(bf16_t*)(ws + WS_WFI + UN_WQK), D, 0.04419417382415922f * LOG2E, nullptr, -1};
              pg8::gemm_phase<2 * D, D, 512>(C.lds, C.wave, g, S, E); }
            { pg8::Gemm g{(const bf16_t*)(ws + WS_WXO + l * SZ_WDD), kv}; VwoOrder S{opq(C.bx) - 128};
              pg8::EpiBf16 E{(bf16_t*)(ws + WS_WFI + UN_VWO), 1024, 1.0f, nullptr, -1};
              pg8::gemm_phase<D, 2 * D, 512>(C.lds, C.wave, g, S, E); }
            __syncthreads();
        }
        mixer_phase<l>(C);
        GRID_BAR();
        gemm_ln_phase<D, false, false>(C, (const bf16_t*)(ws + WS_MIXED), (const bf16_t*)(ws + WS_WMO + l * SZ_WDD), 1.0f, lng + D, lnb + D, l * 4 + 1);
        LOCAL_BAR();
        unsigned char* xw = ws + WS_WFI;
        {
            pg8::Gemm g{XB, (const bf16_t*)(xw + UN_WQK)}; XsOrder S; S.S.init(M, 1024, opq(C.G), opq(C.bx), 64, D, 1024, 256);
            pg8::EpiSoftmax E{(bf16_t*)(ws + WS_UNION + UN_P), 1024};
            pg8::gemm_phase<64, D, D, decltype(E), decltype(S), M * 64>(C.lds, C.wave, g, S, E);
        }
        LOCAL_BAR();
        gemm_ln_phase<1024, false, false>(C, (const bf16_t*)(ws + WS_UNION + UN_P), (const bf16_t*)(xw + UN_VWO), 1.0f, lng + 2 * D, lnb + 2 * D, l * 4 + 2, 2048u * 1024u);
        LOCAL_BAR();
        ffn_block<false, l == DEPTH - 1, l != DEPTH - 1>(C, bar, (const bf16_t*)(ws + WS_WFI + (size_t)(l * 2 + 1) * SZ_WFI), (const bf16_t*)(ws + WS_WFO + (size_t)(l * 2 + 1) * SZ_WFO), lng + 3 * D, lnb + 3 * D, l * 4 + 3);
}

__global__ void __launch_bounds__(NWAVES * 64, 2) hybrid_fwd(Args args) {
    extern __shared__ __attribute__((aligned(16))) unsigned char lds_raw[];
    Ctx C;
    C.lds = (LAS unsigned char*)lds_raw;
    C.wave = __builtin_amdgcn_readfirstlane(threadIdx.x >> 6);
    C.G = gridDim.x; C.bx = blockIdx.x; C.gw = C.bx * NWAVES + C.wave; C.NGW = C.G * NWAVES;
    C.ws = args.ws; C.out = ARG_OUT(); C.ctl = (unsigned*)(args.ws + WS_CTL);
    volatile LAS unsigned* MISC = (volatile LAS unsigned*)(C.lds + MISC_OFF);
    for (int u = threadIdx.x; u < 128; u += NWAVES * 64) ((LAS unsigned*)(C.lds + LDSCTL_OFF))[u] = 0u;
    __syncthreads();
    XcdBarrier bar = xcd_barrier_post(C.ctl + CW_BAR, MISC + 8);
    unsigned char* ws = args.ws;
    bf16_t* XB = (bf16_t*)(ws + WS_XB); bf16_t* MEMB = (bf16_t*)(ws + WS_MEMB);

    {
        LAS float* scr = (LAS float*)(C.lds + C.wave * 16640);
        int rot = 0;
        for (int lj = 0; lj < 4; ++lj) {
            rot = transpose_matrix(ARG_IN(I_FWI) + (size_t)lj * D * 2 * DFF, D, 2 * DFF, 2 * DFF, (bf16_t*)(ws + WS_WFI + lj * SZ_WFI), scr, C.gw, C.NGW, MapFfnIn(), rot, true);
            rot = transpose_matrix(ARG_IN(I_FWO) + (size_t)lj * DFF * D, DFF, D, D, (bf16_t*)(ws + WS_WFO + lj * SZ_WFO), scr, C.gw, C.NGW, MapId(), rot, true);
        }
        for (int l = 0; l < DEPTH; ++l) {
            rot = transpose_matrix(ARG_IN(I_WIN) + (size_t)l * D * NIN, D, NIN, NPROJ, (bf16_t*)(ws + WS_WMI + l * SZ_WMI), scr, C.gw, C.NGW, MapMixIn(), rot, true);
            rot = transpose_matrix(ARG_IN(I_WOUT) + (size_t)l * D * D, D, D, D, (bf16_t*)(ws + WS_WMO + l * SZ_WDD), scr, C.gw, C.NGW, MapId(), rot, true);
            rot = transpose_matrix(ARG_IN(I_XWKV) + (size_t)l * D * 2 * D, D, 2 * D, 2 * D, (bf16_t*)(ws + WS_WXKV + l * SZ_WKV), scr, C.gw, C.NGW, MapId(), rot);
            rot = transpose_matrix(ARG_IN(I_XWO) + (size_t)l * D * D, D, D, D, (bf16_t*)(ws + WS_WXO + l * SZ_WDD), scr, C.gw, C.NGW, MapId(), rot);
        }
        const size_t gt = (size_t)C.bx * (NWAVES * 64) + C.wave * 64 + lane_id(), NGT = (size_t)C.G * (NWAVES * 64);
        cvt_copy_xb(ARG_IN(I_X), XB, (size_t)M * D, gt, NGT);
        cvt_copy(ARG_IN(I_MEM), MEMB, (size_t)BATCH * NMEM * D, gt, NGT);
        for (int l = 0; l < DEPTH; ++l) cvt_copy(ARG_IN(I_XWQ) + (size_t)l * D * D, (bf16_t*)(ws + WS_WXQ + l * SZ_WDD), (size_t)D * D, gt, NGT);
    }
    GRID_BAR();
    xcd_local_setup(bar);
    layer_body<0>(C, bar);
    layer_body<1>(C, bar);
}

extern "C" void kernel_launch(void* const* d_in, const int* in_sizes, int n_in, void* d_out, int out_size, void* d_ws, size_t ws_size, hipStream_t stream) {
    static int grid = 0;
    if (grid == 0) {
        if (n_in != 21 || out_size != M * D || ws_size < WS_END) { fprintf(stderr, "kernel_launch: unexpected problem (n_in %d out %d ws %zu, need %zu)\n", n_in, out_size, ws_size, (size_t)WS_END); grid = -1; return; }
        int dev = 0, cus = 0, per_cu = 0;
        if (hipGetDevice(&dev) != hipSuccess || hipDeviceGetAttribute(&cus, hipDeviceAttributeMultiprocessorCount, dev) != hipSuccess) { grid = -1; return; }
        if (hipFuncSetAttribute((const void*)hybrid_fwd, hipFuncAttributeMaxDynamicSharedMemorySize, LDS_BYTES) != hipSuccess) { fprintf(stderr, "kernel_launch: hipFuncSetAttribute failed\n"); grid = -1; return; }
        if (hipOccupancyMaxActiveBlocksPerMultiprocessor(&per_cu, (const void*)hybrid_fwd, NWAVES * 64, LDS_BYTES) != hipSuccess || per_cu < 1) { fprintf(stderr, "kernel_launch: occupancy query says %d\n", per_cu); (void)hipGetLastError(); grid = -1; return; }
        if (cus != 256) { fprintf(stderr, "kernel_launch: built for a 256-CU device (fused LayerNorm phases deal 256 units per round), got %d\n", cus); grid = -1; return; }
        grid = cus;
    }
    if (grid < 0) return;
    if (hipMemsetAsync((char*)d_ws + WS_CTL, 0, CTL_ZERO_BYTES, stream) != hipSuccess) return;
    Args a{};
    for (int i = 0; i < 21; ++i) a.in[i] = (const float*)d_in[i];
    a.out = (float*)d_out; a.ws = (unsigned char*)d_ws;
    hipLaunchKernelGGL(hybrid_fwd, dim3(grid), dim3(NWAVES * 64), LDS_BYTES, stream, a);
}
```
